# Optimizing an MI355X kernel written in HIP

```python
import jax, jax.numpy as jnp
from jax import lax
import numpy as np

D_MODEL = 1024
BATCH = 4
SEQ = 4096
DEPTH = 1

GRID_W = 64
HEAD_DIM = 64
D_ATTN = D_MODEL // 2
N_Q_HEADS = D_ATTN // HEAD_DIM
N_KV_HEADS = 2
Q_PER_KV = N_Q_HEADS // N_KV_HEADS
D_KV = N_KV_HEADS * HEAD_DIM
Q_BLOCK = 128
ROPE_THETA = 10000.0
AXIS_DIM = HEAD_DIM // 2
N_FREQ = AXIS_DIM // 2
D_LRU = D_MODEL // 2
LRU_BLOCKS = 8
LRU_BLOCK_W = D_LRU // LRU_BLOCKS
LRU_C = 8.0
CONV_W = 4
CONV_PAD = (2, 1)
N_DIR = 2
D_MIX = D_ATTN + D_LRU
D_IN = D_ATTN + 2 * D_KV + 2 * D_LRU
D_FF = 4 * D_MODEL
D_PLE = 256
NORM_EPS = 1e-6

kernel_name = "hybrid_gqa_rglru_encoder_layer"


def rms_norm(x, g):
    xf = x.astype(jnp.float32)
    y = xf * lax.rsqrt(jnp.mean(xf * xf, axis=-1, keepdims=True) + NORM_EPS)
    return (y * g.astype(jnp.float32)).astype(x.dtype)


def _rotate(x, cos, sin):
    x1, x2 = jnp.split(x, 2, axis=-1)
    return jnp.concatenate([x1 * cos - x2 * sin, x2 * cos + x1 * sin], axis=-1)


def axial_rope(x, cos_r, sin_r, cos_c, sin_c):
    xf = x.astype(jnp.float32)
    xr, xc = jnp.split(xf, 2, axis=-1)
    out = jnp.concatenate([_rotate(xr, cos_r, sin_r), _rotate(xc, cos_c, sin_c)], axis=-1)
    return out.astype(x.dtype)


def grid_rope_tables(seq_len):
    rows = seq_len // GRID_W
    row = jnp.repeat(jnp.arange(rows, dtype=jnp.float32), GRID_W)
    col = jnp.tile(jnp.arange(GRID_W, dtype=jnp.float32), rows)
    inv_freq = ROPE_THETA ** (-jnp.arange(N_FREQ, dtype=jnp.float32) / N_FREQ)
    ang_r = row[:, None, None] * inv_freq
    ang_c = col[:, None, None] * inv_freq
    return jnp.cos(ang_r), jnp.sin(ang_r), jnp.cos(ang_c), jnp.sin(ang_c)


def block_attention(q, k, v):
    b, s = q.shape[0], q.shape[1]
    nb = s // Q_BLOCK
    scale = HEAD_DIM ** -0.5
    qb = q.reshape(b, nb, Q_BLOCK, N_KV_HEADS, Q_PER_KV, HEAD_DIM).transpose(1, 0, 2, 3, 4, 5)

    def attend(q_blk):
        sc = jnp.einsum('bqhgd,bkhd->bhgqk', q_blk, k, preferred_element_type=jnp.float32) * scale
        pr = jax.nn.softmax(sc, axis=-1)
        return jnp.einsum('bhgqk,bkhd->bqhgd', pr.astype(v.dtype), v)

    o = lax.map(attend, qb)
    return o.transpose(1, 0, 2, 3, 4, 5).reshape(b, s, D_ATTN)


def _lin_combine(c1, c2):
    a1, b1 = c1
    a2, b2 = c2
    return a1 * a2, a2 * b1 + b2


def bidirectional_rglru(xc, wa, ba, wx, bx, lam):
    b, s = xc.shape[0], xc.shape[1]
    xh = xc.reshape(b, s, LRU_BLOCKS, LRU_BLOCK_W)
    ga = jnp.einsum('bsnk,enkj->ebsnj', xh, wa).reshape(N_DIR, b, s, D_LRU) + ba[:, None, None, :]
    gx = jnp.einsum('bsnk,enkj->ebsnj', xh, wx).reshape(N_DIR, b, s, D_LRU) + bx[:, None, None, :]
    r = jax.nn.sigmoid(ga.astype(jnp.float32))
    i = jax.nn.sigmoid(gx.astype(jnp.float32))
    log_a = LRU_C * r * jax.nn.log_sigmoid(lam.astype(jnp.float32))[:, None, None, :]
    a = jnp.exp(log_a)
    u = jnp.sqrt(-jnp.expm1(2.0 * log_a)) * (i * xc.astype(jnp.float32)[None])
    _, h_fwd = lax.associative_scan(_lin_combine, (a[0], u[0]), axis=1)
    _, h_bwd = lax.associative_scan(_lin_combine, (a[1], u[1]), axis=1, reverse=True)
    return (h_fwd + h_bwd).astype(xc.dtype)


def setup_inputs(seed: int = 0) -> dict:
    key = jax.random.key(seed)
    ks = jax.random.split(key, 24)
    f32 = jnp.float32
    nrm = lambda k, shape, s: jax.random.normal(k, shape, f32) * s
    gain = lambda k, shape: 1.0 + 0.02 * jax.random.normal(k, shape, f32)
    u = jax.random.uniform(ks[12], (DEPTH, N_DIR, D_LRU), f32, 0.9, 0.999)
    a0 = u ** (1.0 / LRU_C)
    lam = jnp.log(a0) - jnp.log1p(-a0)
    return {
        "x": nrm(ks[0], (BATCH, SEQ, D_MODEL), 1.0),
        "p": nrm(ks[1], (DEPTH, BATCH, SEQ, D_PLE), 1.0),
        "mix_norm": gain(ks[2], (DEPTH, D_MODEL)),
        "w_in": nrm(ks[3], (DEPTH, D_MODEL, D_IN), D_MODEL ** -0.5),
        "q_norm": gain(ks[4], (DEPTH, HEAD_DIM)),
        "k_norm": gain(ks[5], (DEPTH, HEAD_DIM)),
        "conv_w": nrm(ks[6], (DEPTH, CONV_W, D_LRU), CONV_W ** -0.5),
        "conv_b": nrm(ks[7], (DEPTH, D_LRU), 0.01),
        "lru_wa": nrm(ks[8], (DEPTH, N_DIR, LRU_BLOCKS, LRU_BLOCK_W, LRU_BLOCK_W), LRU_BLOCK_W ** -0.5),
        "lru_ba": nrm(ks[9], (DEPTH, N_DIR, D_LRU), 0.01),
        "lru_wx": nrm(ks[10], (DEPTH, N_DIR, LRU_BLOCKS, LRU_BLOCK_W, LRU_BLOCK_W), LRU_BLOCK_W ** -0.5),
        "lru_bx": nrm(ks[11], (DEPTH, N_DIR, D_LRU), 0.01),
        "lru_lambda": lam,
        "attn_out_norm": gain(ks[13], (DEPTH, D_ATTN)),
        "lru_out_norm": gain(ks[14], (DEPTH, D_LRU)),
        "w_out": nrm(ks[15], (DEPTH, D_MIX, D_MODEL), D_MIX ** -0.5),
        "mlp_norm": gain(ks[16], (DEPTH, D_MODEL)),
        "w_up": nrm(ks[17], (DEPTH, D_MODEL, D_FF), D_MODEL ** -0.5),
        "w_down": nrm(ks[18], (DEPTH, D_FF, D_MODEL), D_FF ** -0.5),
        "ple_norm": gain(ks[19], (DEPTH, D_MODEL)),
        "w_ple_gate": nrm(ks[20], (DEPTH, D_MODEL, D_MODEL), D_MODEL ** -0.5),
        "w_ple_proj": nrm(ks[21], (DEPTH, D_PLE, D_MODEL), D_PLE ** -0.5),
        "final_norm": gain(ks[22], (D_MODEL,)),
    }


def reference(x, p, mix_norm, w_in, q_norm, k_norm, conv_w, conv_b, lru_wa, lru_ba,
              lru_wx, lru_bx, lru_lambda, attn_out_norm, lru_out_norm, w_out,
              mlp_norm, w_up, w_down, ple_norm, w_ple_gate, w_ple_proj, final_norm):
    b, s = x.shape[0], x.shape[1]
    cos_r, sin_r, cos_c, sin_c = grid_rope_tables(s)
    h = x
    for l in range(DEPTH):
        hn = rms_norm(h, mix_norm[l])
        z = hn @ w_in[l]
        q, k, v, xr, xg = jnp.split(
            z, [D_ATTN, D_ATTN + D_KV, D_ATTN + 2 * D_KV, D_ATTN + 2 * D_KV + D_LRU], axis=-1)
        q = rms_norm(q.reshape(b, s, N_Q_HEADS, HEAD_DIM), q_norm[l])
        k = rms_norm(k.reshape(b, s, N_KV_HEADS, HEAD_DIM), k_norm[l])
        v = v.reshape(b, s, N_KV_HEADS, HEAD_DIM)
        q = axial_rope(q, cos_r, sin_r, cos_c, sin_c)
        k = axial_rope(k, cos_r, sin_r, cos_c, sin_c)
        q = q.reshape(b, s, N_KV_HEADS, Q_PER_KV, HEAD_DIM)
        y_attn = block_attention(q, k, v)
        xc = lax.conv_general_dilated(
            xr, conv_w[l][:, None, :], window_strides=(1,), padding=[CONV_PAD],
            dimension_numbers=('NWC', 'WIO', 'NWC'), feature_group_count=D_LRU) + conv_b[l]
        hr = bidirectional_rglru(xc, lru_wa[l], lru_ba[l], lru_wx[l], lru_bx[l], lru_lambda[l])
        y_lru = hr * jax.nn.gelu(xg)
        y = jnp.concatenate([rms_norm(y_attn, attn_out_norm[l]), rms_norm(y_lru, lru_out_norm[l])], axis=-1)
        h = h + y @ w_out[l]
        m = rms_norm(h, mlp_norm[l]) @ w_up[l]
        h = h + jnp.square(jax.nn.relu(m)) @ w_down[l]
        gate = jax.nn.sigmoid((rms_norm(h, ple_norm[l]) @ w_ple_gate[l]).astype(jnp.float32)).astype(h.dtype)
        h = h + gate * (p[l] @ w_ple_proj[l])
    return rms_norm(h, final_norm)
```

```cpp
#include <hip/hip_runtime.h>
#include <cstdio>
#include <cstdint>

constexpr int BATCH = 4, SEQ = 4096, DM = 1024, T = BATCH * SEQ;
constexpr int DATT = 512, NQH = 8, NKVH = 2, HD = 64, DKV = 128, DLRU = 512, NBLK = 8, BW = 64;
constexpr int DIN = 1792, DFF = 4096, DPLE = 256, GRIDW = 64;
constexpr float EPS = 1e-6f;
constexpr float C2 = 0.125f * 1.4426950408889634f;

typedef unsigned short bf16_t;
__device__ __forceinline__ unsigned f2bf(float f) { unsigned u = __float_as_uint(f); return (u + 0x7fffu + ((u >> 16) & 1u)) >> 16; }
__device__ __forceinline__ float bf2f(bf16_t h) { return __uint_as_float(((unsigned)h) << 16); }

constexpr size_t MiB = 1u << 20;
constexpr size_t WS_CTL = 0;
constexpr size_t WS_PP = 28 * MiB;
constexpr size_t WS_HB = 60 * MiB;
constexpr size_t WS_PB = 92 * MiB;
constexpr size_t WS_K = 100 * MiB;
constexpr size_t WS_V = 104 * MiB;
constexpr size_t WS_Q = 108 * MiB;
constexpr size_t WS_M = 128 * MiB;
constexpr size_t WS_XR = 128 * MiB;
constexpr size_t WS_XG = 144 * MiB;
constexpr size_t WS_Y = 160 * MiB;
constexpr size_t WS_SL = 192 * MiB;
constexpr size_t WS_PF = 208 * MiB;
constexpr size_t WS_PBK = 224 * MiB;

namespace nv {
__device__ __forceinline__ float block_sum(float v, float* red) {
    for (int o = 32; o > 0; o >>= 1) v += __shfl_xor(v, o);
    __syncthreads();
    if ((threadIdx.x & 63) == 0) red[threadIdx.x >> 6] = v;
    __syncthreads();
    const int nw = blockDim.x >> 6; float s = 0.f;
    for (int i = 0; i < nw; ++i) s += red[i];
    return s;
}
__device__ __forceinline__ float gelu_tanh(float x) { const float u = 0.7978845608028654f * (x + 0.044715f * x * x * x); return 0.5f * x * (1.f + tanhf(u)); }
__device__ __forceinline__ float sigmoidf(float x) { return 1.f / (1.f + expf(-x)); }

__device__ __forceinline__ void dot4(const float* As, int K, const float* __restrict__ W, int N, int col, float acc[4]) {
    for (int k = 0; k < K; ++k) { const float w = W[(size_t)k * N + col]; const float4 a = *(const float4*)(As + 4 * k);
        acc[0] += a.x * w; acc[1] += a.y * w; acc[2] += a.z * w; acc[3] += a.w * w; }
}

__global__ void __launch_bounds__(256) s1(const float* __restrict__ x, const float* __restrict__ g, const float* __restrict__ w_in, const float* __restrict__ qn, const float* __restrict__ kn,
                                          bf16_t* Q, bf16_t* K, bf16_t* V, bf16_t* XR, bf16_t* XG) {
    __shared__ float As[DM * 4]; __shared__ float zs[4][DIN]; __shared__ float red[4]; __shared__ float rs[4];
    const int tid = threadIdx.x, t0 = blockIdx.x * 4;
    for (int r = 0; r < 4; ++r) { float s = 0.f; for (int i = tid; i < DM; i += 256) { const float v = x[(size_t)(t0 + r) * DM + i]; s += v * v; }
        s = block_sum(s, red); if (tid == 0) rs[r] = rsqrtf(s / DM + EPS); }
    __syncthreads();
    for (int i = tid; i < DM * 4; i += 256) { const int k = i >> 2, r = i & 3; As[i] = x[(size_t)(t0 + r) * DM + k] * rs[r] * g[k]; }
    __syncthreads();
    for (int j = 0; j < DIN / 256; ++j) { const int col = tid + 256 * j; float acc[4] = {0.f, 0.f, 0.f, 0.f}; dot4(As, DM, w_in, DIN, col, acc);
        for (int r = 0; r < 4; ++r) zs[r][col] = acc[r]; }
    __syncthreads();
    for (int it = tid; it < 4 * 10 * 16; it += 256) {
        const int i = it & 15, hh = (it >> 4) % 10, r = it / 160, t = t0 + r, pos = t % SEQ;
        const float* zh = &zs[r][hh < 8 ? hh * 64 : DATT + (hh - 8) * 64];
        float ss = 0.f; for (int d = 0; d < 64; ++d) ss += zh[d] * zh[d];
        const float rn = rsqrtf(ss / 64.f + EPS); const float* gn = hh < 8 ? qn : kn;
        const float fr = powf(10000.f, -(float)i / 16.f);
        const float ar = (float)(pos / GRIDW) * fr, ac = (float)(pos % GRIDW) * fr;
        const float cr = cosf(ar), sr = sinf(ar), cc = cosf(ac), sc = sinf(ac);
        const float x1 = zh[i] * rn * gn[i], x2 = zh[16 + i] * rn * gn[16 + i], x3 = zh[32 + i] * rn * gn[32 + i], x4 = zh[48 + i] * rn * gn[48 + i];
        float o0 = x1 * cr - x2 * sr, o1 = x2 * cr + x1 * sr, o2 = x3 * cc - x4 * sc, o3 = x4 * cc + x3 * sc;
        if (hh < 8) { o0 *= C2; o1 *= C2; o2 *= C2; o3 *= C2; bf16_t* o = Q + (size_t)t * DATT + hh * 64; o[i] = f2bf(o0); o[16 + i] = f2bf(o1); o[32 + i] = f2bf(o2); o[48 + i] = f2bf(o3); }
        else { bf16_t* o = K + (size_t)t * DKV + (hh - 8) * 64; o[i] = f2bf(o0); o[16 + i] = f2bf(o1); o[32 + i] = f2bf(o2); o[48 + i] = f2bf(o3); }
    }
    for (int it = tid; it < 4 * DKV; it += 256) { const int r = it / DKV, c = it % DKV; V[(size_t)(t0 + r) * DKV + c] = f2bf(zs[r][DATT + DKV + c]); }
    for (int it = tid; it < 4 * DLRU; it += 256) { const int r = it / DLRU, c = it % DLRU;
        XR[(size_t)(t0 + r) * DLRU + c] = f2bf(zs[r][DATT + 2 * DKV + c]);
        XG[(size_t)(t0 + r) * DLRU + c] = f2bf(gelu_tanh(zs[r][DATT + 2 * DKV + DLRU + c])); }
}

__global__ void __launch_bounds__(128) attn(const bf16_t* __restrict__ Q, const bf16_t* __restrict__ K, const bf16_t* __restrict__ V, bf16_t* Y) {
    __shared__ float Ks[64][64]; __shared__ float Vs[64][64];
    const int tid = threadIdx.x, h = blockIdx.y, b = blockIdx.z, kvh = h / 4;
    const size_t trow = (size_t)b * SEQ + blockIdx.x * 128 + tid;
    float q[64], o[64];
#pragma unroll
    for (int d = 0; d < 64; ++d) { q[d] = bf2f(Q[trow * DATT + h * 64 + d]); o[d] = 0.f; }
    float m = -1e30f, l = 0.f;
    for (int kt = 0; kt < SEQ / 64; ++kt) {
        __syncthreads();
        for (int i = tid; i < 64 * 64; i += 128) { const int r = i >> 6, c = i & 63; const size_t kr = (size_t)b * SEQ + kt * 64 + r;
            Ks[r][c] = bf2f(K[kr * DKV + kvh * 64 + c]); Vs[r][c] = bf2f(V[kr * DKV + kvh * 64 + c]); }
        __syncthreads();
        for (int j = 0; j < 64; ++j) {
            float s = 0.f;
#pragma unroll
            for (int d = 0; d < 64; ++d) s += q[d] * Ks[j][d];
            if (s > m) { const float f = exp2f(m - s); l *= f;
#pragma unroll
                for (int d = 0; d < 64; ++d) o[d] *= f; m = s; }
            const float p = exp2f(s - m); l += p;
#pragma unroll
            for (int d = 0; d < 64; ++d) o[d] += p * Vs[j][d];
        }
    }
    const float il = 1.f / l;
#pragma unroll
    for (int d = 0; d < 64; ++d) Y[trow * DM + h * 64 + d] = f2bf(o[d] * il);
}

__global__ void __launch_bounds__(128) lru(const bf16_t* __restrict__ XR, const float* __restrict__ cw, const float* __restrict__ cb, const float* __restrict__ wa, const float* __restrict__ ba,
                                           const float* __restrict__ wx, const float* __restrict__ bx, const float* __restrict__ lam, float* HF, float* HB) {
    __shared__ float xcs[2][64];
    const int tid = threadIdx.x, j = tid & 63, e = tid >> 6, b = blockIdx.x / NBLK, n = blockIdx.x % NBLK, c = n * 64 + j;
    float wav[64], wxv[64];
#pragma unroll
    for (int k = 0; k < 64; ++k) { wav[k] = wa[(((size_t)e * NBLK + n) * 64 + k) * 64 + j]; wxv[k] = wx[(((size_t)e * NBLK + n) * 64 + k) * 64 + j]; }
    const float bav = ba[e * DLRU + c], bxv = bx[e * DLRU + c];
    const float lm = lam[e * DLRU + c]; const float lsg = -log1pf(expf(-lm));
    const float w0 = cw[0 * DLRU + c], w1 = cw[1 * DLRU + c], w2 = cw[2 * DLRU + c], w3 = cw[3 * DLRU + c], cbv = cb[c];
    float* H = e == 0 ? HF : HB; float h = 0.f;
    for (int s = 0; s < SEQ; ++s) {
        const int t = e == 0 ? s : SEQ - 1 - s; const size_t base = (size_t)b * SEQ;
        float xc = cbv;
        if (t - 2 >= 0) xc += w0 * bf2f(XR[(base + t - 2) * DLRU + c]);
        if (t - 1 >= 0) xc += w1 * bf2f(XR[(base + t - 1) * DLRU + c]);
        xc += w2 * bf2f(XR[(base + t) * DLRU + c]);
        if (t + 1 < SEQ) xc += w3 * bf2f(XR[(base + t + 1) * DLRU + c]);
        __syncthreads();
        xcs[e][j] = xc;
        __syncthreads();
        float ga = bav, gx = bxv;
#pragma unroll
        for (int k = 0; k < 64; ++k) { const float v = xcs[e][k]; ga += v * wav[k]; gx += v * wxv[k]; }
        const float r = sigmoidf(ga), ig = sigmoidf(gx), la = 8.f * r * lsg, a = expf(la), u = sqrtf(-expm1f(2.f * la)) * (ig * xc);
        h = a * h + u;
        H[(base + t) * DLRU + c] = h;
    }
}

__global__ void __launch_bounds__(256) merge(bf16_t* Y, const float* __restrict__ HF, const float* __restrict__ HB, const bf16_t* __restrict__ XG, const float* __restrict__ ga, const float* __restrict__ gl) {
    __shared__ float red[4];
    const int tid = threadIdx.x; const size_t t = blockIdx.x;
    float a0 = bf2f(Y[t * DM + tid]), a1 = bf2f(Y[t * DM + 256 + tid]);
    float s = block_sum(a0 * a0 + a1 * a1, red); float rn = rsqrtf(s / DATT + EPS);
    Y[t * DM + tid] = f2bf(a0 * rn * ga[tid]); Y[t * DM + 256 + tid] = f2bf(a1 * rn * ga[256 + tid]);
    float l0 = (HF[t * DLRU + tid] + HB[t * DLRU + tid]) * bf2f(XG[t * DLRU + tid]);
    float l1 = (HF[t * DLRU + 256 + tid] + HB[t * DLRU + 256 + tid]) * bf2f(XG[t * DLRU + 256 + tid]);
    s = block_sum(l0 * l0 + l1 * l1, red); rn = rsqrtf(s / DLRU + EPS);
    Y[t * DM + DATT + tid] = f2bf(l0 * rn * gl[tid]); Y[t * DM + DATT + 256 + tid] = f2bf(l1 * rn * gl[256 + tid]);
}

__global__ void __launch_bounds__(256) s4(const float* __restrict__ x, const bf16_t* __restrict__ Y, const float* __restrict__ w_out, float* H) {
    __shared__ float As[DM * 4];
    const int tid = threadIdx.x, t0 = blockIdx.x * 4;
    for (int i = tid; i < DM * 4; i += 256) { const int k = i >> 2, r = i & 3; As[i] = bf2f(Y[(size_t)(t0 + r) * DM + k]); }
    __syncthreads();
    for (int j = 0; j < DM / 256; ++j) { const int col = tid + 256 * j; float acc[4] = {0.f, 0.f, 0.f, 0.f}; dot4(As, DM, w_out, DM, col, acc);
        for (int r = 0; r < 4; ++r) H[(size_t)(t0 + r) * DM + col] = x[(size_t)(t0 + r) * DM + col] + acc[r]; }
}
__global__ void __launch_bounds__(256) s5(const float* __restrict__ H, const float* __restrict__ g, const float* __restrict__ w_up, bf16_t* M) {
    __shared__ float As[DM * 4]; __shared__ float red[4]; __shared__ float rs[4];
    const int tid = threadIdx.x, t0 = blockIdx.x * 4;
    for (int r = 0; r < 4; ++r) { float s = 0.f; for (int i = tid; i < DM; i += 256) { const float v = H[(size_t)(t0 + r) * DM + i]; s += v * v; }
        s = block_sum(s, red); if (tid == 0) rs[r] = rsqrtf(s / DM + EPS); }
    __syncthreads();
    for (int i = tid; i < DM * 4; i += 256) { const int k = i >> 2, r = i & 3; As[i] = H[(size_t)(t0 + r) * DM + k] * rs[r] * g[k]; }
    __syncthreads();
    for (int j = 0; j < DFF / 256; ++j) { const int col = tid + 256 * j; float acc[4] = {0.f, 0.f, 0.f, 0.f}; dot4(As, DM, w_up, DFF, col, acc);
        for (int r = 0; r < 4; ++r) { const float v = fmaxf(acc[r], 0.f); M[(size_t)(t0 + r) * DFF + col] = f2bf(v * v); } }
}
__global__ void __launch_bounds__(256) s6(float* H, const bf16_t* __restrict__ M, const float* __restrict__ w_down) {
    __shared__ float As[2048 * 4];
    const int tid = threadIdx.x, t0 = blockIdx.x * 4;
    float acc[4][4];
#pragma unroll
    for (int j = 0; j < 4; ++j) for (int r = 0; r < 4; ++r) acc[j][r] = 0.f;
    for (int kh = 0; kh < 2; ++kh) {
        __syncthreads();
        for (int i = tid; i < 2048 * 4; i += 256) { const int k = i >> 2, r = i & 3; As[i] = bf2f(M[(size_t)(t0 + r) * DFF + kh * 2048 + k]); }
        __syncthreads();
#pragma unroll
        for (int j = 0; j < 4; ++j) dot4(As, 2048, w_down + (size_t)kh * 2048 * DM, DM, tid + 256 * j, acc[j]);
    }
#pragma unroll
    for (int j = 0; j < 4; ++j) for (int r = 0; r < 4; ++r) H[(size_t)(t0 + r) * DM + tid + 256 * j] += acc[j][r];
}
__global__ void __launch_bounds__(256) s7(float* H, const float* __restrict__ p, const float* __restrict__ g, const float* __restrict__ w_gate, const float* __restrict__ w_proj, const float* __restrict__ gf) {
    __shared__ float As[DM * 4]; __shared__ float Ps[DPLE * 4]; __shared__ float red[4]; __shared__ float rs[4];
    const int tid = threadIdx.x, t0 = blockIdx.x * 4;
    for (int r = 0; r < 4; ++r) { float s = 0.f; for (int i = tid; i < DM; i += 256) { const float v = H[(size_t)(t0 + r) * DM + i]; s += v * v; }
        s = block_sum(s, red); if (tid == 0) rs[r] = rsqrtf(s / DM + EPS); }
    __syncthreads();
    for (int i = tid; i < DM * 4; i += 256) { const int k = i >> 2, r = i & 3; As[i] = H[(size_t)(t0 + r) * DM + k] * rs[r] * g[k]; }
    for (int i = tid; i < DPLE * 4; i += 256) { const int k = i >> 2, r = i & 3; Ps[i] = p[(size_t)(t0 + r) * DPLE + k]; }
    __syncthreads();
    float h3[4][4];
#pragma unroll
    for (int j = 0; j < 4; ++j) { const int col = tid + 256 * j; float ag[4] = {0.f, 0.f, 0.f, 0.f}, ap[4] = {0.f, 0.f, 0.f, 0.f};
        dot4(As, DM, w_gate, DM, col, ag); dot4(Ps, DPLE, w_proj, DM, col, ap);
        for (int r = 0; r < 4; ++r) h3[j][r] = H[(size_t)(t0 + r) * DM + col] + sigmoidf(ag[r]) * ap[r]; }
#pragma unroll
    for (int r = 0; r < 4; ++r) { float s = 0.f; for (int j = 0; j < 4; ++j) s += h3[j][r] * h3[j][r];
        s = block_sum(s, red); const float rn = rsqrtf(s / DM + EPS);
        for (int j = 0; j < 4; ++j) { const int col = tid + 256 * j; H[(size_t)(t0 + r) * DM + col] = h3[j][r] * rn * gf[col]; } }
}
}

extern "C" void kernel_launch(void* const* d_in, const int* in_sizes, int n_in, void* d_out, int out_size, void* d_ws, size_t ws_size, hipStream_t stream) {
    const float* x = (const float*)d_in[0]; const float* p = (const float*)d_in[1];
    const float* mix_norm = (const float*)d_in[2]; const float* w_in = (const float*)d_in[3]; const float* q_norm = (const float*)d_in[4]; const float* k_norm = (const float*)d_in[5];
    const float* conv_w = (const float*)d_in[6]; const float* conv_b = (const float*)d_in[7]; const float* lru_wa = (const float*)d_in[8]; const float* lru_ba = (const float*)d_in[9];
    const float* lru_wx = (const float*)d_in[10]; const float* lru_bx = (const float*)d_in[11]; const float* lru_lambda = (const float*)d_in[12];
    const float* attn_out_norm = (const float*)d_in[13]; const float* lru_out_norm = (const float*)d_in[14]; const float* w_out = (const float*)d_in[15];
    const float* mlp_norm = (const float*)d_in[16]; const float* w_up = (const float*)d_in[17]; const float* w_down = (const float*)d_in[18];
    const float* ple_norm = (const float*)d_in[19]; const float* w_ple_gate = (const float*)d_in[20]; const float* w_ple_proj = (const float*)d_in[21]; const float* final_norm = (const float*)d_in[22];
    unsigned char* ws = (unsigned char*)d_ws; float* out = (float*)d_out;
    bf16_t* Q = (bf16_t*)(ws + WS_Q); bf16_t* K = (bf16_t*)(ws + WS_K); bf16_t* V = (bf16_t*)(ws + WS_V); bf16_t* XR = (bf16_t*)(ws + WS_XR); bf16_t* XG = (bf16_t*)(ws + WS_XG);
    bf16_t* Y = (bf16_t*)(ws + WS_Y); bf16_t* M = (bf16_t*)(ws + WS_M);
    float* HF = out; float* HB = out + (size_t)T * DLRU;
    nv::s1<<<T / 4, 256, 0, stream>>>(x, mix_norm, w_in, q_norm, k_norm, Q, K, V, XR, XG);
    nv::attn<<<dim3(SEQ / 128, NQH, BATCH), 128, 0, stream>>>(Q, K, V, Y);
    nv::lru<<<BATCH * NBLK, 128, 0, stream>>>(XR, conv_w, conv_b, lru_wa, lru_ba, lru_wx, lru_bx, lru_lambda, HF, HB);
    nv::merge<<<T, 256, 0, stream>>>(Y, HF, HB, XG, attn_out_norm, lru_out_norm);
    nv::s4<<<T / 4, 256, 0, stream>>>(x, Y, w_out, out);
    nv::s5<<<T / 4, 256, 0, stream>>>(out, mlp_norm, w_up, M);
    nv::s6<<<T / 4, 256, 0, stream>>>(out, M, w_down);
    nv::s7<<<T / 4, 256, 0, stream>>>(out, p, ple_norm, w_ple_gate, w_ple_proj, final_norm);
}
```

```cpp
#include <hip/hip_runtime.h>
#include <cstdio>
#include <cstdint>

constexpr int BATCH = 4, SEQ = 4096, DM = 1024, T = BATCH * SEQ;
constexpr int DATT = 512, NQH = 8, NKVH = 2, HD = 64, DKV = 128, DLRU = 512, NBLK = 8, BW = 64;
constexpr int DIN = 1792, DFF = 4096, DPLE = 256, GRIDW = 64;
constexpr float EPS = 1e-6f;
constexpr float C2 = 0.125f * 1.4426950408889634f;

typedef unsigned short bf16_t;
__device__ __forceinline__ unsigned f2bf(float f) { unsigned u = __float_as_uint(f); return (u + 0x7fffu + ((u >> 16) & 1u)) >> 16; }
__device__ __forceinline__ float bf2f(bf16_t h) { return __uint_as_float(((unsigned)h) << 16); }

constexpr size_t MiB = 1u << 20, KiB = 1u << 10;
constexpr size_t WS_CTL = 0, CTL_ZERO_BYTES = 128 * KiB;
constexpr size_t WS_ROPE = 1 * MiB;
constexpr size_t WS_RSX = 1 * MiB + 64 * KiB;
constexpr size_t WS_LW = 1 * MiB + 512 * KiB;
constexpr size_t WS_SS1 = 2 * MiB, WS_SS2 = 3 * MiB, WS_SS3 = 4 * MiB;
constexpr size_t WS_AGG = 5 * MiB;
constexpr size_t WS_WIN = 7 * MiB;
constexpr size_t WS_WOUT = WS_WIN + 3584 * KiB;
constexpr size_t WS_WUP = WS_WOUT + 2 * MiB;
constexpr size_t WS_WDOWN = WS_WUP + 8 * MiB;
constexpr size_t WS_WG = WS_WDOWN + 8 * MiB;
constexpr size_t WS_WP = WS_WG + 2 * MiB;
static_assert(WS_WP + 512 * KiB <= 32 * MiB, "weights");
constexpr size_t WS_PP = 32 * MiB;
constexpr size_t WS_HB = 64 * MiB;
constexpr size_t WS_PB = 96 * MiB;
constexpr size_t WS_K = 104 * MiB;
constexpr size_t WS_V = 108 * MiB;
constexpr size_t WS_Q = 112 * MiB;
constexpr size_t WS_M = 128 * MiB;
constexpr size_t WS_XR = 128 * MiB;
constexpr size_t WS_XG = 144 * MiB;
constexpr size_t WS_Y = 160 * MiB;
constexpr size_t WS_SL = 192 * MiB;
constexpr size_t WS_PF = 208 * MiB;
constexpr size_t WS_PBK = 224 * MiB;
constexpr size_t WS_END = 256 * MiB;

#define MEGA_MASK 0x7f
namespace nv {
__device__ __forceinline__ float block_sum(float v, float* red) {
    for (int o = 32; o > 0; o >>= 1) v += __shfl_xor(v, o);
    __syncthreads();
    if ((threadIdx.x & 63) == 0) red[threadIdx.x >> 6] = v;
    __syncthreads();
    const int nw = blockDim.x >> 6; float s = 0.f;
    for (int i = 0; i < nw; ++i) s += red[i];
    return s;
}
__device__ __forceinline__ float gelu_tanh(float x) { const float u = 0.7978845608028654f * (x + 0.044715f * x * x * x); return 0.5f * x * (1.f + tanhf(u)); }
__device__ __forceinline__ float sigmoidf(float x) { return 1.f / (1.f + expf(-x)); }

__device__ __forceinline__ void dot4(const float* As, int K, const float* __restrict__ W, int N, int col, float acc[4]) {
    for (int k = 0; k < K; ++k) { const float w = W[(size_t)k * N + col]; const float4 a = *(const float4*)(As + 4 * k);
        acc[0] += a.x * w; acc[1] += a.y * w; acc[2] += a.z * w; acc[3] += a.w * w; }
}

__global__ void __launch_bounds__(256) s1(const float* __restrict__ x, const float* __restrict__ g, const float* __restrict__ w_in, const float* __restrict__ qn, const float* __restrict__ kn,
                                          bf16_t* Q, bf16_t* K, bf16_t* V, bf16_t* XR, bf16_t* XG) {
    __shared__ float As[DM * 4]; __shared__ float zs[4][DIN]; __shared__ float red[4]; __shared__ float rs[4];
    const int tid = threadIdx.x, t0 = blockIdx.x * 4;
    for (int r = 0; r < 4; ++r) { float s = 0.f; for (int i = tid; i < DM; i += 256) { const float v = x[(size_t)(t0 + r) * DM + i]; s += v * v; }
        s = block_sum(s, red); if (tid == 0) rs[r] = rsqrtf(s / DM + EPS); }
    __syncthreads();
    for (int i = tid; i < DM * 4; i += 256) { const int k = i >> 2, r = i & 3; As[i] = x[(size_t)(t0 + r) * DM + k] * rs[r] * g[k]; }
    __syncthreads();
    for (int j = 0; j < DIN / 256; ++j) { const int col = tid + 256 * j; float acc[4] = {0.f, 0.f, 0.f, 0.f}; dot4(As, DM, w_in, DIN, col, acc);
        for (int r = 0; r < 4; ++r) zs[r][col] = acc[r]; }
    __syncthreads();
    for (int it = tid; it < 4 * 10 * 16; it += 256) {
        const int i = it & 15, hh = (it >> 4) % 10, r = it / 160, t = t0 + r, pos = t % SEQ;
        const float* zh = &zs[r][hh < 8 ? hh * 64 : DATT + (hh - 8) * 64];
        float ss = 0.f; for (int d = 0; d < 64; ++d) ss += zh[d] * zh[d];
        const float rn = rsqrtf(ss / 64.f + EPS); const float* gn = hh < 8 ? qn : kn;
        const float fr = powf(10000.f, -(float)i / 16.f);
        const float ar = (float)(pos / GRIDW) * fr, ac = (float)(pos % GRIDW) * fr;
        const float cr = cosf(ar), sr = sinf(ar), cc = cosf(ac), sc = sinf(ac);
        const float x1 = zh[i] * rn * gn[i], x2 = zh[16 + i] * rn * gn[16 + i], x3 = zh[32 + i] * rn * gn[32 + i], x4 = zh[48 + i] * rn * gn[48 + i];
        float o0 = x1 * cr - x2 * sr, o1 = x2 * cr + x1 * sr, o2 = x3 * cc - x4 * sc, o3 = x4 * cc + x3 * sc;
        if (hh < 8) { o0 *= C2; o1 *= C2; o2 *= C2; o3 *= C2; bf16_t* o = Q + (size_t)t * DATT + hh * 64; o[i] = f2bf(o0); o[16 + i] = f2bf(o1); o[32 + i] = f2bf(o2); o[48 + i] = f2bf(o3); }
        else { bf16_t* o = K + (size_t)t * DKV + (hh - 8) * 64; o[i] = f2bf(o0); o[16 + i] = f2bf(o1); o[32 + i] = f2bf(o2); o[48 + i] = f2bf(o3); }
    }
    for (int it = tid; it < 4 * DKV; it += 256) { const int r = it / DKV, c = it % DKV; V[(size_t)(t0 + r) * DKV + c] = f2bf(zs[r][DATT + DKV + c]); }
    for (int it = tid; it < 4 * DLRU; it += 256) { const int r = it / DLRU, c = it % DLRU;
        XR[(size_t)(t0 + r) * DLRU + c] = f2bf(zs[r][DATT + 2 * DKV + c]);
        XG[(size_t)(t0 + r) * DLRU + c] = f2bf(gelu_tanh(zs[r][DATT + 2 * DKV + DLRU + c])); }
}

__global__ void __launch_bounds__(128) attn(const bf16_t* __restrict__ Q, const bf16_t* __restrict__ K, const bf16_t* __restrict__ V, bf16_t* Y) {
    __shared__ float Ks[64][64]; __shared__ float Vs[64][64];
    const int tid = threadIdx.x, h = blockIdx.y, b = blockIdx.z, kvh = h / 4;
    const size_t trow = (size_t)b * SEQ + blockIdx.x * 128 + tid;
    float q[64], o[64];
#pragma unroll
    for (int d = 0; d < 64; ++d) { q[d] = bf2f(Q[trow * DATT + h * 64 + d]); o[d] = 0.f; }
    float m = -1e30f, l = 0.f;
    for (int kt = 0; kt < SEQ / 64; ++kt) {
        __syncthreads();
        for (int i = tid; i < 64 * 64; i += 128) { const int r = i >> 6, c = i & 63; const size_t kr = (size_t)b * SEQ + kt * 64 + r;
            Ks[r][c] = bf2f(K[kr * DKV + kvh * 64 + c]); Vs[r][c] = bf2f(V[kr * DKV + kvh * 64 + c]); }
        __syncthreads();
        for (int j = 0; j < 64; ++j) {
            float s = 0.f;
#pragma unroll
            for (int d = 0; d < 64; ++d) s += q[d] * Ks[j][d];
            if (s > m) { const float f = exp2f(m - s); l *= f;
#pragma unroll
                for (int d = 0; d < 64; ++d) o[d] *= f; m = s; }
            const float p = exp2f(s - m); l += p;
#pragma unroll
            for (int d = 0; d < 64; ++d) o[d] += p * Vs[j][d];
        }
    }
    const float il = 1.f / l;
#pragma unroll
    for (int d = 0; d < 64; ++d) Y[trow * DM + h * 64 + d] = f2bf(o[d] * il);
}

__global__ void __launch_bounds__(128) lru(const bf16_t* __restrict__ XR, const float* __restrict__ cw, const float* __restrict__ cb, const float* __restrict__ wa, const float* __restrict__ ba,
                                           const float* __restrict__ wx, const float* __restrict__ bx, const float* __restrict__ lam, float* HF, float* HB) {
    __shared__ float xcs[2][64];
    const int tid = threadIdx.x, j = tid & 63, e = tid >> 6, b = blockIdx.x / NBLK, n = blockIdx.x % NBLK, c = n * 64 + j;
    float wav[64], wxv[64];
#pragma unroll
    for (int k = 0; k < 64; ++k) { wav[k] = wa[(((size_t)e * NBLK + n) * 64 + k) * 64 + j]; wxv[k] = wx[(((size_t)e * NBLK + n) * 64 + k) * 64 + j]; }
    const float bav = ba[e * DLRU + c], bxv = bx[e * DLRU + c];
    const float lm = lam[e * DLRU + c]; const float lsg = -log1pf(expf(-lm));
    const float w0 = cw[0 * DLRU + c], w1 = cw[1 * DLRU + c], w2 = cw[2 * DLRU + c], w3 = cw[3 * DLRU + c], cbv = cb[c];
    float* H = e == 0 ? HF : HB; float h = 0.f;
    for (int s = 0; s < SEQ; ++s) {
        const int t = e == 0 ? s : SEQ - 1 - s; const size_t base = (size_t)b * SEQ;
        float xc = cbv;
        if (t - 2 >= 0) xc += w0 * bf2f(XR[(base + t - 2) * DLRU + c]);
        if (t - 1 >= 0) xc += w1 * bf2f(XR[(base + t - 1) * DLRU + c]);
        xc += w2 * bf2f(XR[(base + t) * DLRU + c]);
        if (t + 1 < SEQ) xc += w3 * bf2f(XR[(base + t + 1) * DLRU + c]);
        __syncthreads();
        xcs[e][j] = xc;
        __syncthreads();
        float ga = bav, gx = bxv;
#pragma unroll
        for (int k = 0; k < 64; ++k) { const float v = xcs[e][k]; ga += v * wav[k]; gx += v * wxv[k]; }
        const float r = sigmoidf(ga), ig = sigmoidf(gx), la = 8.f * r * lsg, a = expf(la), u = sqrtf(-expm1f(2.f * la)) * (ig * xc);
        h = a * h + u;
        H[(base + t) * DLRU + c] = h;
    }
}

__global__ void __launch_bounds__(256) merge(bf16_t* Y, const float* __restrict__ HF, const float* __restrict__ HB, const bf16_t* __restrict__ XG, const float* __restrict__ ga, const float* __restrict__ gl) {
    __shared__ float red[4];
    const int tid = threadIdx.x; const size_t t = blockIdx.x;
    float a0 = bf2f(Y[t * DM + tid]), a1 = bf2f(Y[t * DM + 256 + tid]);
    float s = block_sum(a0 * a0 + a1 * a1, red); float rn = rsqrtf(s / DATT + EPS);
    Y[t * DM + tid] = f2bf(a0 * rn * ga[tid]); Y[t * DM + 256 + tid] = f2bf(a1 * rn * ga[256 + tid]);
    float l0 = (HF[t * DLRU + tid] + HB[t * DLRU + tid]) * bf2f(XG[t * DLRU + tid]);
    float l1 = (HF[t * DLRU + 256 + tid] + HB[t * DLRU + 256 + tid]) * bf2f(XG[t * DLRU + 256 + tid]);
    s = block_sum(l0 * l0 + l1 * l1, red); rn = rsqrtf(s / DLRU + EPS);
    Y[t * DM + DATT + tid] = f2bf(l0 * rn * gl[tid]); Y[t * DM + DATT + 256 + tid] = f2bf(l1 * rn * gl[256 + tid]);
}

__global__ void __launch_bounds__(256) s4(const float* __restrict__ x, const bf16_t* __restrict__ Y, const float* __restrict__ w_out, float* H) {
    __shared__ float As[DM * 4];
    const int tid = threadIdx.x, t0 = blockIdx.x * 4;
    for (int i = tid; i < DM * 4; i += 256) { const int k = i >> 2, r = i & 3; As[i] = bf2f(Y[(size_t)(t0 + r) * DM + k]); }
    __syncthreads();
    for (int j = 0; j < DM / 256; ++j) { const int col = tid + 256 * j; float acc[4] = {0.f, 0.f, 0.f, 0.f}; dot4(As, DM, w_out, DM, col, acc);
        for (int r = 0; r < 4; ++r) H[(size_t)(t0 + r) * DM + col] = x[(size_t)(t0 + r) * DM + col] + acc[r]; }
}
__global__ void __launch_bounds__(256) s5(const float* __restrict__ H, const float* __restrict__ g, const float* __restrict__ w_up, bf16_t* M) {
    __shared__ float As[DM * 4]; __shared__ float red[4]; __shared__ float rs[4];
    const int tid = threadIdx.x, t0 = blockIdx.x * 4;
    for (int r = 0; r < 4; ++r) { float s = 0.f; for (int i = tid; i < DM; i += 256) { const float v = H[(size_t)(t0 + r) * DM + i]; s += v * v; }
        s = block_sum(s, red); if (tid == 0) rs[r] = rsqrtf(s / DM + EPS); }
    __syncthreads();
    for (int i = tid; i < DM * 4; i += 256) { const int k = i >> 2, r = i & 3; As[i] = H[(size_t)(t0 + r) * DM + k] * rs[r] * g[k]; }
    __syncthreads();
    for (int j = 0; j < DFF / 256; ++j) { const int col = tid + 256 * j; float acc[4] = {0.f, 0.f, 0.f, 0.f}; dot4(As, DM, w_up, DFF, col, acc);
        for (int r = 0; r < 4; ++r) { const float v = fmaxf(acc[r], 0.f); M[(size_t)(t0 + r) * DFF + col] = f2bf(v * v); } }
}
__global__ void __launch_bounds__(256) s6(float* H, const bf16_t* __restrict__ M, const float* __restrict__ w_down) {
    __shared__ float As[2048 * 4];
    const int tid = threadIdx.x, t0 = blockIdx.x * 4;
    float acc[4][4];
#pragma unroll
    for (int j = 0; j < 4; ++j) for (int r = 0; r < 4; ++r) acc[j][r] = 0.f;
    for (int kh = 0; kh < 2; ++kh) {
        __syncthreads();
        for (int i = tid; i < 2048 * 4; i += 256) { const int k = i >> 2, r = i & 3; As[i] = bf2f(M[(size_t)(t0 + r) * DFF + kh * 2048 + k]); }
        __syncthreads();
#pragma unroll
        for (int j = 0; j < 4; ++j) dot4(As, 2048, w_down + (size_t)kh * 2048 * DM, DM, tid + 256 * j, acc[j]);
    }
#pragma unroll
    for (int j = 0; j < 4; ++j) for (int r = 0; r < 4; ++r) H[(size_t)(t0 + r) * DM + tid + 256 * j] += acc[j][r];
}
__global__ void __launch_bounds__(256) s7(float* H, const float* __restrict__ p, const float* __restrict__ g, const float* __restrict__ w_gate, const float* __restrict__ w_proj, const float* __restrict__ gf) {
    __shared__ float As[DM * 4]; __shared__ float Ps[DPLE * 4]; __shared__ float red[4]; __shared__ float rs[4];
    const int tid = threadIdx.x, t0 = blockIdx.x * 4;
    for (int r = 0; r < 4; ++r) { float s = 0.f; for (int i = tid; i < DM; i += 256) { const float v = H[(size_t)(t0 + r) * DM + i]; s += v * v; }
        s = block_sum(s, red); if (tid == 0) rs[r] = rsqrtf(s / DM + EPS); }
    __syncthreads();
    for (int i = tid; i < DM * 4; i += 256) { const int k = i >> 2, r = i & 3; As[i] = H[(size_t)(t0 + r) * DM + k] * rs[r] * g[k]; }
    for (int i = tid; i < DPLE * 4; i += 256) { const int k = i >> 2, r = i & 3; Ps[i] = p[(size_t)(t0 + r) * DPLE + k]; }
    __syncthreads();
    float h3[4][4];
#pragma unroll
    for (int j = 0; j < 4; ++j) { const int col = tid + 256 * j; float ag[4] = {0.f, 0.f, 0.f, 0.f}, ap[4] = {0.f, 0.f, 0.f, 0.f};
        dot4(As, DM, w_gate, DM, col, ag); dot4(Ps, DPLE, w_proj, DM, col, ap);
        for (int r = 0; r < 4; ++r) h3[j][r] = H[(size_t)(t0 + r) * DM + col] + sigmoidf(ag[r]) * ap[r]; }
#pragma unroll
    for (int r = 0; r < 4; ++r) { float s = 0.f; for (int j = 0; j < 4; ++j) s += h3[j][r] * h3[j][r];
        s = block_sum(s, red); const float rn = rsqrtf(s / DM + EPS);
        for (int j = 0; j < 4; ++j) { const int col = tid + 256 * j; H[(size_t)(t0 + r) * DM + col] = h3[j][r] * rn * gf[col]; } }
}
}

namespace pg8 {
#define PG8_LAS __attribute__((address_space(3)))
typedef unsigned short bf16_t;
typedef short bf16x8 __attribute__((ext_vector_type(8)));
typedef float f32x4 __attribute__((ext_vector_type(4)));
typedef unsigned u32x4 __attribute__((ext_vector_type(4)));
constexpr int BM = 256, BK = 64, HALF = 128, HTB = HALF * BK * 2  , STAGE_BYTES = 8 * HTB, NXCD = 8, WGM = 8;

__host__ __device__ __forceinline__ int lds_byte(int r, int c) { const int st = (r >> 4) * 2 + (c >> 5), rr = r & 15, cc = c & 31, ob = rr * 64 + cc * 2; return st * 1024 + (ob ^ (((ob >> 9) & 1) << 5)); }
__host__ __device__ __forceinline__ void stage_rc(int b, int& R, int& C) { const int st = b / 1024, sb = b % 1024, swz = sb ^ (((sb >> 9) & 1) << 5); R = (st >> 1) * 16 + swz / 64; C = (st & 1) * 32 + (swz % 64) / 2; }
__host__ __device__ __forceinline__ int perm32(int rho) { const int n = rho >> 4, i = rho & 15; return 8 * (i >> 2) + 4 * n + (i & 3); }

struct Unit { int pm, pn; };
struct Gemm { const bf16_t* A; const bf16_t* Bt; int M, N, K; };

struct StaticOrder {
    int nM, nN, nwg, G, c;
    __host__ __device__ void init(int M, int N, int G_, int c_) { nM = M / BM; nN = N / BM; nwg = nM * nN; G = G_; c = c_; }
    __host__ __device__ bool next(int i, Unit& u) const {
        const long L = (long)i * G + c; if (L >= nwg) return false;
        int wgid = (int)L; { const int q = nwg / NXCD, r = nwg % NXCD, xcd = wgid % NXCD, off = wgid / NXCD; wgid = (xcd < r ? xcd * (q + 1) : r * (q + 1) + (xcd - r) * q) + off; }
        const int nig = WGM * nN, gid = wgid / nig, fm = gid * WGM, gsz = (nM - fm) < WGM ? (nM - fm) : WGM;
        u.pm = fm + ((wgid % nig) % gsz); u.pn = (wgid % nig) / gsz; return true;
    }
    __device__ __forceinline__ void a_ready(const Unit&) const {}
    __device__ __forceinline__ void done(const Unit&) const {}
};

__device__ __forceinline__ unsigned cvt_pk_bf16(float lo, float hi) { unsigned r; asm volatile("v_cvt_pk_bf16_f32 %0, %1, %2" : "=v"(r) : "v"(lo), "v"(hi)); return r; }
typedef float f32x2 __attribute__((ext_vector_type(2)));
__device__ __forceinline__ f32x2 gelu_pk(f32x2 v) {
    const f32x2 av = __builtin_elementwise_abs(v), d = av * 0.2316418882f + 1.0f;
    f32x2 t; t.x = __builtin_amdgcn_rcpf(d.x); t.y = __builtin_amdgcn_rcpf(d.y);
    f32x2 q = t * 0.5307027145f + (-0.7265760135f); q = q * t + 0.7107068705f; q = q * t + (-0.142248368f); q = q * t + 0.127414796f; q = q * t;
    const f32x2 s = (v * v) * (-0.72134752044f);
    f32x2 e; e.x = __builtin_amdgcn_exp2f(s.x); e.y = __builtin_amdgcn_exp2f(s.y);
    const f32x2 m = v * (q * e), r = v - m;
    f32x2 o; o.x = v.x < 0.f ? m.x : r.x; o.y = v.y < 0.f ? m.y : r.y; return o;
}

template <int ACT  > struct EpiBf16 {
    static constexpr bool PERM = true, AFTER_DRAIN = false; static_assert(ACT == 0 || ACT == 1, "EpiBf16: ACT is 0 (none) or 1 (gelu_pk)");
    bf16_t* O; int ldc; const float* bias; int split_cols; size_t split_stride; float scale0;
    __device__ __forceinline__ void operator()(const f32x4 (&acc)[2][2][4][2], const Unit& u, int wr, int wc, int fr, int fq) const {
        const int row0 = u.pm * BM + wr * 64 + fr; int colt = u.pn * BM; bf16_t* base = O;
        float sc = 1.f; if (split_cols) { const int t = colt / split_cols; base += (size_t)t * split_stride; colt -= t * split_cols; if (t == 0) sc = scale0; }
        const int col0 = colt + wc * 32 + 8 * fq, bcol0 = u.pn * BM + wc * 32 + 8 * fq;
        f32x4 bv[2][2];
#pragma unroll
        for (int bj = 0; bj < 2; ++bj)
#pragma unroll
            for (int n = 0; n < 2; ++n) bv[bj][n] = bias ? *(const f32x4*)(bias + bcol0 + bj * HALF + 4 * n) : (f32x4){0.f, 0.f, 0.f, 0.f};
#pragma unroll
        for (int ai = 0; ai < 2; ++ai)
#pragma unroll
            for (int m = 0; m < 4; ++m) { bf16_t* rowp = base + (size_t)(row0 + ai * HALF + m * 16) * ldc + col0;
#pragma unroll
                for (int bj = 0; bj < 2; ++bj) { f32x4 v0 = acc[ai][bj][m][0] + bv[bj][0], v1 = acc[ai][bj][m][1] + bv[bj][1];
                    if (ACT == 1) { f32x2 a = gelu_pk((f32x2){v0[0], v0[1]}), b = gelu_pk((f32x2){v0[2], v0[3]}), c = gelu_pk((f32x2){v1[0], v1[1]}), d = gelu_pk((f32x2){v1[2], v1[3]});
                        v0 = (f32x4){a.x, a.y, b.x, b.y}; v1 = (f32x4){c.x, c.y, d.x, d.y}; }
                    v0 = v0 * sc; v1 = v1 * sc; u32x4 w; w.x = cvt_pk_bf16(v0[0], v0[1]); w.y = cvt_pk_bf16(v0[2], v0[3]); w.z = cvt_pk_bf16(v1[0], v1[1]); w.w = cvt_pk_bf16(v1[2], v1[3]);
                    *(u32x4*)(rowp + bj * HALF) = w; } }
    }
};
typedef unsigned u32x2 __attribute__((ext_vector_type(2)));
__device__ __forceinline__ float wsum4(float s) { s += __shfl_xor(s, 16); s += __shfl_xor(s, 32); return s; }
__device__ __forceinline__ float dot4f(const f32x4 a) { return (a[0] * a[0] + a[1] * a[1]) + (a[2] * a[2] + a[3] * a[3]); }
__device__ __forceinline__ u32x2 pack4(const f32x4 v) { u32x2 w; w.x = cvt_pk_bf16(v[0], v[1]); w.y = cvt_pk_bf16(v[2], v[3]); return w; }
__device__ __forceinline__ f32x4 unpack4(const u32x2 w) { f32x4 v; v[0] = __uint_as_float(w.x << 16); v[1] = __uint_as_float(w.x & 0xffff0000u); v[2] = __uint_as_float(w.y << 16); v[3] = __uint_as_float(w.y & 0xffff0000u); return v; }
__device__ __forceinline__ float gelu_tanh_fast(float x) {
    const float e = __builtin_amdgcn_exp2f(-2.302208198f * (x + 0.044715f * x * x * x)); return x * __builtin_amdgcn_rcpf(1.0f + e);
}
__device__ __forceinline__ float sigmoid_fast(float x) { return __builtin_amdgcn_rcpf(1.0f + __builtin_amdgcn_exp2f(-1.4426950408889634f * x)); }
__device__ __forceinline__ float rstd16(const float* ss) {
    const f32x4 a = *(const f32x4*)(ss), b = *(const f32x4*)(ss + 4), c = *(const f32x4*)(ss + 8), d = *(const f32x4*)(ss + 12);
    const float s = ((a[0] + a[1]) + (a[2] + a[3])) + ((b[0] + b[1]) + (b[2] + b[3])) + ((c[0] + c[1]) + (c[2] + c[3])) + ((d[0] + d[1]) + (d[2] + d[3]));
    return rsqrtf(s * (1.0f / 1024.0f) + EPS);
}

struct EpiIn {
    static constexpr bool PERM = false, AFTER_DRAIN = false;
    const float* rsx; const float* qn; const float* kn; const float* rope;
    bf16_t *Q, *K, *V, *XR, *XG;
    __device__ __forceinline__ void operator()(const f32x4 (&acc)[2][2][4][2], const Unit& u, int wr, int wc, int fr, int fq) const {
        const int rowb = u.pm * BM + wr * 64 + fr;
        if (u.pn < 2 || (u.pn == 2 && wc < 2)) {
            const bool isq = u.pn < 2;
            const float* gn = isq ? qn : kn; const float osc = isq ? C2 : 1.0f;
            f32x4 g[2][2];
#pragma unroll
            for (int bj = 0; bj < 2; ++bj)
#pragma unroll
                for (int n = 0; n < 2; ++n) g[bj][n] = *(const f32x4*)(gn + 32 * bj + 16 * n + 4 * fq) * osc;
#pragma unroll
            for (int ai = 0; ai < 2; ++ai) {
                const int ridx = (4 * u.pm + 2 * ai + wr) & 63;
                const f32x4 cr = *(const f32x4*)(rope + ridx * 16 + 4 * fq), sr = *(const f32x4*)(rope + 1024 + ridx * 16 + 4 * fq);
#pragma unroll
                for (int m = 0; m < 4; ++m) {
                    const int t = rowb + ai * HALF + m * 16; const float rs = rsx[t]; const int cidx = 16 * m + fr;
                    const f32x4 cc = *(const f32x4*)(rope + cidx * 16 + 4 * fq), sc = *(const f32x4*)(rope + 1024 + cidx * 16 + 4 * fq);
                    f32x4 v00 = acc[ai][0][m][0] * rs, v01 = acc[ai][0][m][1] * rs, v10 = acc[ai][1][m][0] * rs, v11 = acc[ai][1][m][1] * rs;
                    const float ss = wsum4((dot4f(v00) + dot4f(v01)) + (dot4f(v10) + dot4f(v11)));
                    const float rn = rsqrtf(ss * (1.0f / 64.0f) + EPS);
                    v00 = v00 * rn * g[0][0]; v01 = v01 * rn * g[0][1]; v10 = v10 * rn * g[1][0]; v11 = v11 * rn * g[1][1];
                    const f32x4 o0 = v00 * cr - v01 * sr, o1 = v01 * cr + v00 * sr, o2 = v10 * cc - v11 * sc, o3 = v11 * cc + v10 * sc;
                    bf16_t* dst = isq ? Q + (size_t)t * 512 + (u.pn * 4 + wc) * 64 + 4 * fq : K + (size_t)t * 128 + wc * 64 + 4 * fq;
                    *(u32x2*)(dst) = pack4(o0); *(u32x2*)(dst + 16) = pack4(o1); *(u32x2*)(dst + 32) = pack4(o2); *(u32x2*)(dst + 48) = pack4(o3);
                    asm volatile("" ::: "memory");
                }
            }
        } else if (u.pn == 2) {
#pragma unroll
            for (int ai = 0; ai < 2; ++ai)
#pragma unroll
                for (int m = 0; m < 4; ++m) {
                    const int t = rowb + ai * HALF + m * 16; const float rs = rsx[t];
                    bf16_t* dst = V + (size_t)t * 128 + (wc - 2) * 64 + 4 * fq;
#pragma unroll
                    for (int bj = 0; bj < 2; ++bj)
#pragma unroll
                        for (int n = 0; n < 2; ++n) *(u32x2*)(dst + 32 * bj + 16 * n) = pack4(acc[ai][bj][m][n] * rs);
                }
        } else {
            const bool isg = u.pn >= 5;
            bf16_t* base = (isg ? XG + (u.pn - 5) * 256 : XR + (u.pn - 3) * 256) + wc * 32 + 8 * fq;
#pragma unroll
            for (int ai = 0; ai < 2; ++ai)
#pragma unroll
                for (int m = 0; m < 4; ++m) {
                    const int t = rowb + ai * HALF + m * 16; const float rs = rsx[t];
#pragma unroll
                    for (int bj = 0; bj < 2; ++bj) {
                        f32x4 v0 = acc[ai][bj][m][0] * rs, v1 = acc[ai][bj][m][1] * rs;
                        if (isg) {
#pragma unroll
                            for (int e = 0; e < 4; ++e) { v0[e] = gelu_tanh_fast(v0[e]); v1[e] = gelu_tanh_fast(v1[e]); }
                        }
                        u32x4 w; w.x = cvt_pk_bf16(v0[0], v0[1]); w.y = cvt_pk_bf16(v0[2], v0[3]); w.z = cvt_pk_bf16(v1[0], v1[1]); w.w = cvt_pk_bf16(v1[2], v1[3]);
                        *(u32x4*)(base + (size_t)t * 512 + bj * HALF) = w;
                    }
                }
        }
    }
};

struct EpiRes {
    static constexpr bool PERM = false, AFTER_DRAIN = false;
    const float* base; float* out; bf16_t* hb; float* ss;
    __device__ __forceinline__ void operator()(const f32x4 (&acc)[2][2][4][2], const Unit& u, int wr, int wc, int fr, int fq) const {
        const int rowb = u.pm * BM + wr * 64 + fr, col0 = u.pn * BM + wc * 32 + 4 * fq;
#pragma unroll
        for (int ai = 0; ai < 2; ++ai)
#pragma unroll
            for (int m = 0; m < 4; ++m) {
                const int t = rowb + ai * HALF + m * 16; const size_t off = (size_t)t * 1024 + col0; float s = 0.f;
#pragma unroll
                for (int bj = 0; bj < 2; ++bj)
#pragma unroll
                    for (int n = 0; n < 2; ++n) {
                        const f32x4 o = *(const f32x4*)(base + off + bj * HALF + n * 16) + acc[ai][bj][m][n];
                        *(f32x4*)(out + off + bj * HALF + n * 16) = o; *(u32x2*)(hb + off + bj * HALF + n * 16) = pack4(o); s += dot4f(o);
                    }
                s = wsum4(s); if (fq == 0) ss[(size_t)t * 16 + u.pn * 4 + wc] = s;
            }
    }
};

struct EpiUp {
    static constexpr bool PERM = true, AFTER_DRAIN = false;
    const float* ss; bf16_t* M;
    __device__ __forceinline__ void operator()(const f32x4 (&acc)[2][2][4][2], const Unit& u, int wr, int wc, int fr, int fq) const {
        const int rowb = u.pm * BM + wr * 64 + fr, col0 = u.pn * BM + wc * 32 + 8 * fq;
#pragma unroll
        for (int ai = 0; ai < 2; ++ai)
#pragma unroll
            for (int m = 0; m < 4; ++m) {
                const int t = rowb + ai * HALF + m * 16; const float rs = rstd16(ss + (size_t)t * 16);
#pragma unroll
                for (int bj = 0; bj < 2; ++bj) {
                    f32x4 v0 = acc[ai][bj][m][0] * rs, v1 = acc[ai][bj][m][1] * rs;
#pragma unroll
                    for (int e = 0; e < 4; ++e) { const float a = fmaxf(v0[e], 0.f), b = fmaxf(v1[e], 0.f); v0[e] = a * a; v1[e] = b * b; }
                    u32x4 w; w.x = cvt_pk_bf16(v0[0], v0[1]); w.y = cvt_pk_bf16(v0[2], v0[3]); w.z = cvt_pk_bf16(v1[0], v1[1]); w.w = cvt_pk_bf16(v1[2], v1[3]);
                    *(u32x4*)(M + (size_t)t * 4096 + col0 + bj * HALF) = w;
                }
            }
    }
};

struct EpiGate {
    static constexpr bool PERM = false, AFTER_DRAIN = false;
    const float* ss2; const bf16_t* pp; float* out; float* ss3;
    __device__ __forceinline__ void operator()(const f32x4 (&acc)[2][2][4][2], const Unit& u, int wr, int wc, int fr, int fq) const {
        const int rowb = u.pm * BM + wr * 64 + fr, col0 = u.pn * BM + wc * 32 + 4 * fq;
#pragma unroll
        for (int ai = 0; ai < 2; ++ai)
#pragma unroll
            for (int m = 0; m < 4; ++m) {
                const int t = rowb + ai * HALF + m * 16; const float rs = rstd16(ss2 + (size_t)t * 16); const size_t off = (size_t)t * 1024 + col0; float s = 0.f;
#pragma unroll
                for (int bj = 0; bj < 2; ++bj)
#pragma unroll
                    for (int n = 0; n < 2; ++n) {
                        const f32x4 pv = unpack4(*(const u32x2*)(pp + off + bj * HALF + n * 16)); const f32x4 a = acc[ai][bj][m][n] * rs; f32x4 o = *(const f32x4*)(out + off + bj * HALF + n * 16);
#pragma unroll
                        for (int e = 0; e < 4; ++e) o[e] += sigmoid_fast(a[e]) * pv[e];
                        *(f32x4*)(out + off + bj * HALF + n * 16) = o; s += dot4f(o);
                    }
                s = wsum4(s); if (fq == 0) ss3[(size_t)t * 16 + u.pn * 4 + wc] = s;
            }
    }
};

struct PpOrder {
    int c;
    __device__ __forceinline__ bool next(int i, Unit& u) const { if (c < 192 || i >= 4) return false; const int idx = (c - 192) * 4 + i; u.pm = idx >> 2; u.pn = idx & 3; return true; }
    __device__ __forceinline__ void a_ready(const Unit&) const {}
    __device__ __forceinline__ void done(const Unit&) const {}
};
template <class Epi, class Sched, bool ALIGN_EPI = false, bool SP2 = false>
__device__ __forceinline__ void gemm_phase(PG8_LAS unsigned char* lds, const Gemm g, const Sched& S, const Epi& E) {
    const int tid = threadIdx.x, wid = __builtin_amdgcn_readfirstlane(tid >> 6), lane = tid & 63, wr = wid >> 2, wc = wid & 3, fr = lane & 15, fq = lane >> 4;
    const int K = g.K, nt = K / BK;
    unsigned voffA[2], voffB[2];
#pragma unroll
    for (int i = 0; i < 2; ++i) { int R, C; stage_rc(tid * 16 + i * 8192, R, C); const int Rb = Epi::PERM ? ((R & ~31) + perm32(R & 31)) : R;
        voffA[i] = (unsigned)(R * K + C) * 2u; voffB[i] = (unsigned)(Rb * K + C) * 2u; }
    const size_t kstep = (size_t)(BK * 2);
    const size_t hstep = (size_t)HALF * K * 2;
    const size_t tstep = 2 * hstep;
    const unsigned ldsw = (unsigned)wid * 1024u;
    const int aoff = lds_byte(wr * 64 + fr, fq * 8), boff = lds_byte(wc * 32 + fr, fq * 8);
#define PG8_SA(b, h) (((b) * 2 + (h)) * HTB)
#define PG8_SB(b, h) ((4 + (b) * 2 + (h)) * HTB)
#define PG8_STAGE(bufoff, gbase, voff) do { _Pragma("unroll") for (int _i = 0; _i < 2; ++_i) \
        __builtin_amdgcn_global_load_lds((const unsigned*)((const char*)(gbase) + (voff)[_i]), (PG8_LAS unsigned*)(lds + (bufoff) + ldsw + _i * 8192), 16, 0, 0); } while (0)
#define PG8_LDA(dst, b, h) do { _Pragma("unroll") for (int m = 0; m < 4; ++m) _Pragma("unroll") for (int k = 0; k < 2; ++k) dst[m][k] = *(const PG8_LAS bf16x8*)(lds + PG8_SA(b, h) + aoff + m * 2048 + k * 1024); } while (0)
#define PG8_LDB(dst, b, h) do { _Pragma("unroll") for (int n = 0; n < 2; ++n) _Pragma("unroll") for (int k = 0; k < 2; ++k) dst[n][k] = *(const PG8_LAS bf16x8*)(lds + PG8_SB(b, h) + boff + n * 2048 + k * 1024); } while (0)
#define PG8_MMA(ai, bj, At, Bt) do { __builtin_amdgcn_s_setprio(1); _Pragma("unroll") for (int m = 0; m < 4; ++m) _Pragma("unroll") for (int n = 0; n < 2; ++n) _Pragma("unroll") for (int k = 0; k < 2; ++k) \
        acc[ai][bj][m][n] = __builtin_amdgcn_mfma_f32_16x16x32_bf16(Bt[n][k], At[m][k], acc[ai][bj][m][n], 0, 0, 0); __builtin_amdgcn_s_setprio(0); } while (0)
#define PG8_WAIT_V(n) asm volatile("s_waitcnt vmcnt(" #n ")" ::: "memory")
#define PG8_WAIT_L(n) asm volatile("s_waitcnt lgkmcnt(" #n ")" ::: "memory")
#define PG8_BAR __builtin_amdgcn_s_barrier()
#define PG8_SCHED __builtin_amdgcn_sched_barrier(0)
    Unit cur, nxt; int ui = 0;
    if (!S.next(0, cur)) return;
    f32x4 acc[2][2][4][2];
#pragma unroll
    for (int a = 0; a < 2; ++a)
#pragma unroll
        for (int b = 0; b < 2; ++b)
#pragma unroll
            for (int m = 0; m < 4; ++m)
#pragma unroll
                for (int n = 0; n < 2; ++n) acc[a][b][m][n] = (f32x4){0.f, 0.f, 0.f, 0.f};
    bf16x8 At[4][2], B0[2][2], B1[2][2];
    const char* cA = (const char*)g.A + (size_t)cur.pm * tstep; const char* cB = (const char*)g.Bt + (size_t)cur.pn * tstep;
    S.a_ready(cur);
    if constexpr (SP2) {
        PG8_STAGE(PG8_SB(0, 0), cB, voffB); PG8_STAGE(PG8_SB(0, 1), cB + hstep, voffB); PG8_STAGE(PG8_SA(0, 0), cA, voffA); PG8_STAGE(PG8_SA(0, 1), cA + hstep, voffA);
        if (wr == 1) PG8_BAR;
        PG8_WAIT_V(2); PG8_BAR;
        PG8_STAGE(PG8_SB(1, 0), cB + kstep, voffB); PG8_STAGE(PG8_SA(1, 0), cA + kstep, voffA); PG8_STAGE(PG8_SB(1, 1), cB + hstep + kstep, voffB);
        PG8_WAIT_V(6); PG8_BAR;
    } else {
        PG8_STAGE(PG8_SB(0, 0), cB, voffB); PG8_STAGE(PG8_SA(0, 0), cA, voffA); PG8_STAGE(PG8_SB(0, 1), cB + hstep, voffB); PG8_STAGE(PG8_SA(0, 1), cA + hstep, voffA);
        if (wr == 1) PG8_BAR;
        PG8_WAIT_V(4); PG8_BAR;
        PG8_STAGE(PG8_SB(1, 0), cB + kstep, voffB); PG8_STAGE(PG8_SA(1, 0), cA + kstep, voffA); PG8_STAGE(PG8_SB(1, 1), cB + hstep + kstep, voffB);
        PG8_WAIT_V(6); PG8_BAR;
    }
    for (;;) {
        const bool has_next = S.next(ui + 1, nxt);
        const char* nA = has_next ? (const char*)g.A + (size_t)nxt.pm * tstep : cA; const char* nB = has_next ? (const char*)g.Bt + (size_t)nxt.pn * tstep : cB;
        for (int t = 0; t < nt; t += 2) {
            const bool last = (t == nt - 2);
            const char* a1 = cA + (size_t)(t + 1) * kstep;
            const char* a2 = last ? nA : cA + (size_t)(t + 2) * kstep; const char* b2 = last ? nB : cB + (size_t)(t + 2) * kstep;
            const char* a3 = a2 + kstep; const char* b3 = b2 + kstep;
            if (last && has_next) S.a_ready(nxt);
            if constexpr (SP2) {
            PG8_LDB(B0, 0, 0); PG8_LDB(B1, 0, 1); PG8_SCHED; PG8_LDA(At, 0, 0); PG8_STAGE(PG8_SA(1, 1), a1 + hstep, voffA);
            PG8_WAIT_V(8); PG8_WAIT_L(0); PG8_BAR; PG8_MMA(0, 0, At, B0); PG8_MMA(0, 1, At, B1); PG8_BAR; PG8_SCHED;
            PG8_LDA(At, 0, 1); PG8_STAGE(PG8_SB(0, 0), b2, voffB); PG8_STAGE(PG8_SB(0, 1), b2 + hstep, voffB); PG8_STAGE(PG8_SA(0, 0), a2, voffA);
            PG8_WAIT_V(8); PG8_WAIT_L(0); PG8_BAR; PG8_MMA(1, 0, At, B0); PG8_MMA(1, 1, At, B1); PG8_BAR; PG8_SCHED;
            PG8_LDB(B0, 1, 0); PG8_LDB(B1, 1, 1); PG8_SCHED; PG8_LDA(At, 1, 0); PG8_STAGE(PG8_SA(0, 1), a2 + hstep, voffA);
            PG8_WAIT_V(8); PG8_WAIT_L(0); PG8_BAR; PG8_MMA(0, 0, At, B0); PG8_MMA(0, 1, At, B1); PG8_BAR; PG8_SCHED;
            PG8_LDA(At, 1, 1); PG8_STAGE(PG8_SB(1, 0), b3, voffB); PG8_STAGE(PG8_SB(1, 1), b3 + hstep, voffB); PG8_STAGE(PG8_SA(1, 0), a3, voffA);
            PG8_WAIT_V(8); PG8_WAIT_L(0); PG8_BAR; PG8_MMA(1, 0, At, B0); PG8_MMA(1, 1, At, B1); PG8_BAR; PG8_SCHED;
            } else {
            PG8_LDB(B0, 0, 0); PG8_SCHED; PG8_LDA(At, 0, 0); PG8_STAGE(PG8_SA(1, 1), a1 + hstep, voffA);
            PG8_WAIT_L(8); PG8_BAR; PG8_WAIT_L(0); PG8_MMA(0, 0, At, B0); PG8_BAR; PG8_SCHED;
            PG8_LDB(B1, 0, 1); PG8_STAGE(PG8_SB(0, 0), b2, voffB);
            PG8_BAR; PG8_WAIT_L(0); PG8_MMA(0, 1, At, B1); PG8_BAR;
            PG8_LDA(At, 0, 1); PG8_STAGE(PG8_SA(0, 0), a2, voffA);
            PG8_BAR; PG8_WAIT_L(0); PG8_MMA(1, 0, At, B0); PG8_BAR; PG8_SCHED;
            PG8_STAGE(PG8_SB(0, 1), b2 + hstep, voffB);
            PG8_WAIT_V(6); PG8_BAR; PG8_MMA(1, 1, At, B1); PG8_BAR;
            PG8_LDB(B0, 1, 0); PG8_SCHED; PG8_LDA(At, 1, 0); PG8_STAGE(PG8_SA(0, 1), a2 + hstep, voffA);
            PG8_WAIT_L(8); PG8_BAR; PG8_WAIT_L(0); PG8_MMA(0, 0, At, B0); PG8_BAR; PG8_SCHED;
            PG8_LDB(B1, 1, 1); PG8_STAGE(PG8_SB(1, 0), b3, voffB);
            PG8_BAR; PG8_WAIT_L(0); PG8_MMA(0, 1, At, B1); PG8_BAR;
            PG8_LDA(At, 1, 1); PG8_STAGE(PG8_SA(1, 0), a3, voffA);
            PG8_BAR; PG8_WAIT_L(0); PG8_MMA(1, 0, At, B0); PG8_BAR; PG8_SCHED;
            PG8_STAGE(PG8_SB(1, 1), b3 + hstep, voffB);
            PG8_WAIT_V(6); PG8_BAR; PG8_MMA(1, 1, At, B1); PG8_BAR;
            }
        }
        if constexpr (ALIGN_EPI) { if (wr == 0) PG8_BAR; }
        if constexpr (!Epi::AFTER_DRAIN) { E(acc, cur, wr, wc, fr, fq); S.done(cur); }
        if (!has_next) break;
#pragma unroll
        for (int a = 0; a < 2; ++a)
#pragma unroll
            for (int b = 0; b < 2; ++b)
#pragma unroll
                for (int m = 0; m < 4; ++m)
#pragma unroll
                    for (int n = 0; n < 2; ++n) acc[a][b][m][n] = (f32x4){0.f, 0.f, 0.f, 0.f};
        cur = nxt; cA = nA; cB = nB; ++ui;
        if constexpr (ALIGN_EPI) { if (wr == 1) PG8_BAR; }
    }
    PG8_WAIT_V(0);
    if constexpr (!ALIGN_EPI) { if (wr == 0) PG8_BAR; }
    PG8_BAR;
    if constexpr (Epi::AFTER_DRAIN) { E.fused(acc, cur, wr, wc, fr, fq, lds, wid, lane); S.done(cur); }
#undef PG8_SA
#undef PG8_SB
#undef PG8_STAGE
#undef PG8_LDA
#undef PG8_LDB
#undef PG8_MMA
#undef PG8_WAIT_V
#undef PG8_WAIT_L
#undef PG8_BAR
#undef PG8_SCHED
}
}

#ifndef PG8_SP2
#define PG8_SP2 true
#endif
#ifndef PG8_ALIGN
#define PG8_ALIGN true
#endif
#include <hip/hip_bf16.h>
#include <cmath>
namespace attn_body {
using bf16=__hip_bfloat16;
using bf16x8=__attribute__((ext_vector_type(8)))short;
using s16x4=__attribute__((ext_vector_type(4)))short;
using f32x16=__attribute__((ext_vector_type(16)))float;
using u32x4=__attribute__((ext_vector_type(4)))unsigned;
constexpr int BATCH=4,NHEAD=8,SEQ=4096,D=64,QP=512,KP=128,OP=1024;
constexpr int NW=8,QBLK=32,QB=QBLK*NW,KVBLK=64,NQB=SEQ/QB;
constexpr int ATTN_UNIT_ROWS=QB;
__device__ __forceinline__ int crow(int r,int hi){return (r&3)+8*(r>>2)+4*hi;}
#define SBAR() __builtin_amdgcn_sched_barrier(0)
__device__ __forceinline__ void cmask(f32x16&p0,f32x16&p1,int jb,int qrel,int hi){
  const float NEG=-INFINITY; int kb=64*jb+4*hi;
  #pragma unroll
  for(int r=0;r<16;++r){int kv=kb+(r&3)+8*(r>>2); if(kv>qrel)p0[r]=NEG; if(kv+32>qrel)p1[r]=NEG;}
}

constexpr int NSLOT=3, SLOTB=8192;
constexpr int LDS_K=0, LDS_V=NSLOT*SLOTB, LDS_WS=2*NSLOT*SLOTB, LDS_OST=LDS_WS+NW*64*4, LDS_BYTES=LDS_OST+NW*4096;
constexpr float C2=0.125f*1.4426950408889634f;
__device__ __forceinline__ void glds16(const void*gsrc,unsigned lds_dst){unsigned keep;
  asm volatile("s_mov_b32 %0, m0\n\ts_mov_b32 m0, %2\n\ts_nop 0\n\tglobal_load_lds_dwordx4 %1, off\n\ts_mov_b32 m0, %0":"=&s"(keep):"v"(gsrc),"s"(lds_dst):"memory");}
__device__ __forceinline__ float max3f(float a,float b,float c){float r;asm("v_max3_f32 %0, %1, %2, %3":"=v"(r):"v"(a),"v"(b),"v"(c));return r;}
__device__ __forceinline__ float max2f(float a,float b){float r;asm("v_max_f32_e32 %0, %1, %2":"=v"(r):"v"(a),"v"(b));return r;}
__device__ __forceinline__ float fadd_s(float a,float b){float r;asm("v_add_f32_e32 %0, %1, %2":"=v"(r):"v"(a),"v"(b));return r;}
__device__ __forceinline__ float fsub_s(float a,float b){float r;asm("v_sub_f32_e32 %0, %1, %2":"=v"(r):"v"(a),"v"(b));return r;}
typedef float f32x2_t __attribute__((ext_vector_type(2))); typedef __bf16 bf16x2_t __attribute__((ext_vector_type(2)));
__device__ __forceinline__ unsigned cvtpk_s(float lo,float hi){f32x2_t v={lo,hi};bf16x2_t b=__builtin_convertvector(v,bf16x2_t);return __builtin_bit_cast(unsigned,b);}
#define WAIT_BAR(N) asm volatile("s_waitcnt vmcnt(" #N ") lgkmcnt(0)\n\ts_barrier":::"memory")

__device__ __forceinline__ void qkt(f32x16&p0,f32x16&p1,const char*Kslot,const bf16x8*qr,const f32x16&negm,int r32,int hi){
  const char*kb=Kslot+hi*1024+r32*16;
  #pragma unroll
  for(int d0=0;d0<4;++d0){
    const bf16x8 b0=*reinterpret_cast<const bf16x8*>(kb+d0*2048);
    const bf16x8 b1=*reinterpret_cast<const bf16x8*>(kb+d0*2048+512);
    if(d0==0){p0=__builtin_amdgcn_mfma_f32_32x32x16_bf16(b0,qr[0],negm,0,0,0);p1=__builtin_amdgcn_mfma_f32_32x32x16_bf16(b1,qr[0],negm,0,0,0);}
    else{p0=__builtin_amdgcn_mfma_f32_32x32x16_bf16(b0,qr[d0],p0,0,0,0);p1=__builtin_amdgcn_mfma_f32_32x32x16_bf16(b1,qr[d0],p1,0,0,0);}}
}
typedef __attribute__((address_space(3))) const char* lds_cptr;
typedef short v4i16_t __attribute__((ext_vector_type(4)));
__device__ __forceinline__ void kload8(bf16x8*kf,lds_cptr kp){
  kf[0]=*(const __attribute__((address_space(3))) bf16x8*)(kp);      kf[1]=*(const __attribute__((address_space(3))) bf16x8*)(kp+512);
  kf[2]=*(const __attribute__((address_space(3))) bf16x8*)(kp+2048); kf[3]=*(const __attribute__((address_space(3))) bf16x8*)(kp+2560);
  kf[4]=*(const __attribute__((address_space(3))) bf16x8*)(kp+4096); kf[5]=*(const __attribute__((address_space(3))) bf16x8*)(kp+4608);
  kf[6]=*(const __attribute__((address_space(3))) bf16x8*)(kp+6144); kf[7]=*(const __attribute__((address_space(3))) bf16x8*)(kp+6656);
}
__device__ __forceinline__ void kload2(bf16x8*kf,lds_cptr kp,int j){ kf[2*j]=*(const __attribute__((address_space(3))) bf16x8*)(kp+j*2048); kf[2*j+1]=*(const __attribute__((address_space(3))) bf16x8*)(kp+j*2048+512); }
__device__ __forceinline__ s16x4 vtr(lds_cptr p){ return __builtin_bit_cast(s16x4,__builtin_amdgcn_ds_read_tr16_b64_v4i16((__attribute__((address_space(3))) v4i16_t*)p)); }
__device__ __forceinline__ float rowmax(const f32x16&p0,const f32x16&p1){
  float a=max3f(p0[0],p0[1],p1[0]),b=max3f(p0[2],p0[3],p1[1]);a=max3f(a,p1[2],p1[3]);
  #pragma unroll
  for(int r=4;r<16;r+=4){a=max3f(a,p0[r],p0[r+1]);b=max3f(b,p0[r+2],p0[r+3]);a=max3f(a,p1[r],p1[r+1]);b=max3f(b,p1[r+2],p1[r+3]);}
  const float m=max2f(a,b);
  auto rr=__builtin_amdgcn_permlane32_swap(__float_as_uint(m),__float_as_uint(m),false,false);
  return max2f(__uint_as_float(rr[0]),__uint_as_float(rr[1]));
}
__device__ __forceinline__ void pv(f32x16*o,int vb,bf16x8 pa0,bf16x8 pa1,bf16x8 pa2,bf16x8 pa3){
  #pragma unroll
  for(int d0=0;d0<2;++d0){s16x4 lo[4],hi[4];
    #pragma unroll
    for(int ks=0;ks<4;++ks){
      asm volatile("ds_read_b64_tr_b16 %0,%1 offset:%c2":"=&v"(lo[ks]):"v"(vb),"i"(d0*4096+ks*1024):"memory");
      asm volatile("ds_read_b64_tr_b16 %0,%1 offset:%c2":"=&v"(hi[ks]):"v"(vb),"i"(d0*4096+ks*1024+512):"memory");}
    asm volatile("s_waitcnt lgkmcnt(0)":::"memory");SBAR();
    #define PK(k) (bf16x8){lo[k][0],lo[k][1],lo[k][2],lo[k][3],hi[k][0],hi[k][1],hi[k][2],hi[k][3]}
    o[d0]=__builtin_amdgcn_mfma_f32_32x32x16_bf16(pa0,PK(0),o[d0],0,0,0);
    o[d0]=__builtin_amdgcn_mfma_f32_32x32x16_bf16(pa1,PK(1),o[d0],0,0,0);
    o[d0]=__builtin_amdgcn_mfma_f32_32x32x16_bf16(pa2,PK(2),o[d0],0,0,0);
    o[d0]=__builtin_amdgcn_mfma_f32_32x32x16_bf16(pa3,PK(3),o[d0],0,0,0);
    #undef PK
  }
}

#ifndef ATTN_STORE16
#define ATTN_STORE16(p,v) (*(u32x4*)(p)=(v))
#endif
template<int THRL> __device__ __forceinline__ void attn_unit(int b,int h,int qb,const bf16*Q,const bf16*__restrict__ K,const bf16*__restrict__ V,bf16*O,char*shm){
  const int tid=threadIdx.x,lane=tid&63,r32=lane&31,hi=lane>>5; const int wid=__builtin_amdgcn_readfirstlane(tid>>6);
  const long rowbase=(long)b*SEQ; const int q0=qb*QB;
  const bf16*Qw=Q+(rowbase+q0+wid*QBLK)*QP+h*D;
  const bf16*Kh=K+rowbase*KP+(h>>2)*D,*Vh=V+rowbase*KP+(h>>2)*D;
  const unsigned lds0=(unsigned)(uintptr_t)shm;
  float*wsf=(float*)(shm+LDS_WS)+wid*64;
  const bf16*ksrc=Kh+(long)lane*KP+wid*8;
  const bf16*vsrc=Vh+(long)(16*(wid&3)+(lane>>2))*KP+(wid>>2)*32+(lane&3)*8;
  const unsigned kdst=lds0+LDS_K+wid*1024, vdst=lds0+LDS_V+wid*1024;
  #define DMA_K(t,slot) glds16(ksrc+(long)(t)*KVBLK*KP,(unsigned)__builtin_amdgcn_readfirstlane(kdst+(slot)))
  #define DMA_V(t,slot) glds16(vsrc+(long)(t)*KVBLK*KP,(unsigned)__builtin_amdgcn_readfirstlane(vdst+(slot)))
  const int vb0=(int)(lds0+LDS_V)+((lane>>4)&1)*32+(lane&3)*8+(4*hi+((lane&15)>>2))*64;
  const char*Kbase=shm+LDS_K; bf16x8 kf[8];
  const lds_cptr shm3=(lds_cptr)shm; const lds_cptr kp0=shm3+LDS_K+hi*1024+r32*16; const lds_cptr vp0=shm3+LDS_V+((lane>>4)&1)*32+(lane&3)*8+(4*hi+((lane&15)>>2))*64;
  const int NT=SEQ/KVBLK;
  DMA_K(0,0);DMA_V(0,0);DMA_K(1,SLOTB);
  bf16x8 qr[4];
  #pragma unroll
  for(int d0=0;d0<4;++d0)qr[d0]=*reinterpret_cast<const bf16x8*>(&Qw[(long)r32*QP+d0*16+hi*8]);
  float mhat=0.f,l_reg=0.f;f32x16 o[2];o[0]=f32x16{};o[1]=f32x16{};f32x16 negm=f32x16{};asm volatile("":"+v"(negm));
  const int qrel=wid*QBLK+r32;
  #define CMASK(P0,P1,t) do{}while(0)
  bool resc=false;
  #define START(P0,P1) do{ const float rm=rowmax(P0,P1); resc=false; \
    { const float dl=rm; mhat=fadd_s(mhat,dl); \
      _Pragma("unroll") for(int r=0;r<16;++r){P0[r]=fsub_s(P0[r],dl);P1[r]=fsub_s(P1[r],dl);} \
      _Pragma("unroll") for(int r=0;r<16;++r)negm[r]=-mhat; asm volatile("":"+v"(negm)); } \
    _Pragma("unroll") for(int r=0;r<16;++r)P0[r]=__builtin_amdgcn_exp2f(P0[r]); }while(0)
  #define RESC() do{ if(resc){ asm volatile("s_waitcnt lgkmcnt(0)":::"memory"); \
      _Pragma("unroll") for(int d_=0;d_<2;++d_) _Pragma("unroll") for(int r=0;r<16;++r)o[d_][r]*=wsf[crow(r,hi)]; } }while(0)
  f32x16 pA0,pA1,pB0,pB1;
  int sl_prev=0,sl_cur=0,sl_next=SLOTB;
  #define ROT() do{sl_prev=sl_cur;sl_cur=sl_next;sl_next=(sl_next==(NSLOT-1)*SLOTB)?0:sl_next+SLOTB;}while(0)
  DMA_K(2,2*SLOTB);
  WAIT_BAR(3);
  qkt(pA0,pA1,Kbase,qr,negm,r32,hi);asm volatile("s_nop 15\n\ts_nop 7":"+v"(pA0),"+v"(pA1));CMASK(pA0,pA1,0);
  START(pA0,pA1);
  _Pragma("unroll") for(int r=0;r<16;++r)pA1[r]=__builtin_amdgcn_exp2f(pA1[r]);
  WAIT_BAR(0);
  DMA_K(3,0);DMA_V(1,SLOTB);
  ROT();
  kload8(kf,kp0+sl_cur);
  WAIT_BAR(2);
  s16x4 vlo[8],vhi[8]; u32x4 pw0,pw1,pw2,pw3;
  #define PKW(P,B) cvtpk_s(P[B],P[B+1])
  #define PAF(k) __builtin_bit_cast(bf16x8,pw##k)
  #define VFR(i) (bf16x8){vlo[i][0],vlo[i][1],vlo[i][2],vlo[i][3],vhi[i][0],vhi[i][1],vhi[i][2],vhi[i][3]}
  #define PIN(x) asm volatile("":"+v"(x))
  #define MX3(a,b,c) __builtin_fmaxf(__builtin_fmaxf((a),(b)),(c))
  #define GAPA(MF,A0,A1,A2,A3,W0,W1,PW) do{ MF; sacc+=A0; sacc+=A1; sacc+=A2; sacc+=A3; PIN(sacc); W0; W1; PIN(PW); SBAR(); }while(0)
  #define EX(v) __builtin_amdgcn_exp2f(v)
  #define GAPB(MF,X,B) do{ MF; X[B]=EX(X[B]); X[B+1]=EX(X[B+1]); X[B+2]=EX(X[B+2]); X[B+3]=EX(X[B+3]); PIN(X); SBAR(); }while(0)
  #define VRD(i) do{ vlo[i]=vtr(vp_+(((i)>>2)*4096+((i)&3)*1024)); vhi[i]=vtr(vp_+(((i)>>2)*4096+((i)&3)*1024+512)); }while(0)
  #define KRD(G,j) do{ if(G){ kload2(kf,kp0+sl_next,j); SBAR(); } }while(0)
  #define STEP(C0,C1,P0,P1,t,GK,GV,GL) do{ SBAR(); \
    const lds_cptr vp_=vp0+sl_prev; \
    VRD(0); SBAR(); float sacc=(P0[0]+P0[1]); \
    GAPA(C0=__builtin_amdgcn_mfma_f32_32x32x16_bf16(kf[0],qr[0],negm,0,0,0), P0[2],P0[3],P0[4],P0[5],     pw0[0]=PKW(P0,0), pw0[1]=PKW(P0,2), pw0); \
    VRD(4); SBAR(); GAPA(C1=__builtin_amdgcn_mfma_f32_32x32x16_bf16(kf[1],qr[0],negm,0,0,0), P0[6],P0[7],P0[8],P0[9],     pw0[2]=PKW(P0,4), pw0[3]=PKW(P0,6), pw0); \
    VRD(1); SBAR(); GAPA(C0=__builtin_amdgcn_mfma_f32_32x32x16_bf16(kf[2],qr[1],C0,0,0,0),   P0[10],P0[11],P0[12],P0[13], pw1[0]=PKW(P0,8), pw1[1]=PKW(P0,10), pw1); \
    VRD(5); SBAR(); GAPA(C1=__builtin_amdgcn_mfma_f32_32x32x16_bf16(kf[3],qr[1],C1,0,0,0),   P0[14],P0[15],P1[0],P1[1],   pw1[2]=PKW(P0,12),pw1[3]=PKW(P0,14), pw1); \
    VRD(2); SBAR(); GAPA(C0=__builtin_amdgcn_mfma_f32_32x32x16_bf16(kf[4],qr[2],C0,0,0,0),   P1[2],P1[3],P1[4],P1[5],     pw2[0]=PKW(P1,0), pw2[1]=PKW(P1,2), pw2); \
    VRD(6); SBAR(); GAPA(C1=__builtin_amdgcn_mfma_f32_32x32x16_bf16(kf[5],qr[2],C1,0,0,0),   P1[6],P1[7],P1[8],P1[9],     pw2[2]=PKW(P1,4), pw2[3]=PKW(P1,6), pw2); \
    VRD(3); SBAR(); GAPA(C0=__builtin_amdgcn_mfma_f32_32x32x16_bf16(kf[6],qr[3],C0,0,0,0),   P1[10],P1[11],P1[12],P1[13], pw3[0]=PKW(P1,8), pw3[1]=PKW(P1,10), pw3); \
    VRD(7); SBAR(); GAPA(C1=__builtin_amdgcn_mfma_f32_32x32x16_bf16(kf[7],qr[3],C1,0,0,0),   P1[14],P1[15],0.f,0.f,       pw3[2]=PKW(P1,12),pw3[3]=PKW(P1,14), pw3); \
    l_reg+=sacc; \
    if(GK){DMA_K((t)+3,sl_cur);} if(GV){DMA_V((t)+1,sl_next);} \
    CMASK(C0,C1,t); \
    { float a=MX3(C0[0],C0[1],C1[0]),b=MX3(C0[2],C0[3],C1[1]); a=MX3(a,C1[2],C1[3]); \
      _Pragma("unroll") for(int r=4;r<16;r+=4){a=MX3(a,C0[r],C0[r+1]);b=MX3(b,C0[r+2],C0[r+3]);a=MX3(a,C1[r],C1[r+1]);b=MX3(b,C1[r+2],C1[r+3]);} \
      float rm=__builtin_fmaxf(a,b); { auto rr=__builtin_amdgcn_permlane32_swap(__float_as_uint(rm),__float_as_uint(rm),false,false); rm=__builtin_fmaxf(__uint_as_float(rr[0]),__uint_as_float(rr[1])); } \
      resc=false; \
      if(__builtin_expect(__any(rm>(float)THRL),0)){ const float dl=__builtin_fmaxf(rm,0.f); mhat+=dl; \
        _Pragma("unroll") for(int r=0;r<16;++r){C0[r]-=dl;C1[r]-=dl;} \
        _Pragma("unroll") for(int r=0;r<16;++r)negm[r]=-mhat; asm volatile("":"+v"(negm)); \
        const float f=__builtin_amdgcn_exp2f(-dl); l_reg*=f; if(hi==0)wsf[r32]=f; resc=true; } } \
    SBAR(); \
    GAPB(o[0]=__builtin_amdgcn_mfma_f32_32x32x16_bf16(PAF(0),VFR(0),o[0],0,0,0), C0,0); \
    GAPB(o[1]=__builtin_amdgcn_mfma_f32_32x32x16_bf16(PAF(0),VFR(4),o[1],0,0,0), C0,4); \
    KRD(GL,0); GAPB(o[0]=__builtin_amdgcn_mfma_f32_32x32x16_bf16(PAF(1),VFR(1),o[0],0,0,0), C0,8); \
    KRD(GL,1); GAPB(o[1]=__builtin_amdgcn_mfma_f32_32x32x16_bf16(PAF(1),VFR(5),o[1],0,0,0), C0,12); \
    KRD(GL,2); GAPB(o[0]=__builtin_amdgcn_mfma_f32_32x32x16_bf16(PAF(2),VFR(2),o[0],0,0,0), C1,0); \
    KRD(GL,3); GAPB(o[1]=__builtin_amdgcn_mfma_f32_32x32x16_bf16(PAF(2),VFR(6),o[1],0,0,0), C1,4); \
    GAPB(o[0]=__builtin_amdgcn_mfma_f32_32x32x16_bf16(PAF(3),VFR(3),o[0],0,0,0), C1,8); \
    GAPB(o[1]=__builtin_amdgcn_mfma_f32_32x32x16_bf16(PAF(3),VFR(7),o[1],0,0,0), C1,12); \
    }while(0)
  int t=1;
  #undef CMASK
  #define CMASK(P0,P1,t) do{}while(0)
  for(;t+5<NT;t+=2){
    STEP(pB0,pB1,pA0,pA1,t,true,true,true);     WAIT_BAR(2); RESC(); ROT();
    STEP(pA0,pA1,pB0,pB1,t+1,true,true,true);   WAIT_BAR(2); RESC(); ROT();
  }
  #undef CMASK
  #define CMASK(P0,P1,t) do{}while(0)
  #define ENDW(tt) do{ if((tt)+3<NT){WAIT_BAR(2);} else if((tt)+2<NT){WAIT_BAR(1);} else {WAIT_BAR(0);} }while(0)
  for(;t+1<NT;t+=2){
    STEP(pB0,pB1,pA0,pA1,t,(t+3<NT),(t+1<NT),(t+1<NT));       ENDW(t);   RESC(); ROT();
    STEP(pA0,pA1,pB0,pB1,t+1,(t+4<NT),(t+2<NT),(t+2<NT));     ENDW(t+1); RESC(); ROT();
  }
  STEP(pB0,pB1,pA0,pA1,NT-1,false,false,false); RESC();
  { float sacc=pB0[0]+pB0[1]; _Pragma("unroll") for(int r=2;r<16;++r)sacc+=pB0[r]; _Pragma("unroll") for(int r=0;r<16;++r)sacc+=pB1[r]; l_reg+=sacc;
    pw0=(u32x4){PKW(pB0,0),PKW(pB0,2),PKW(pB0,4),PKW(pB0,6)};pw1=(u32x4){PKW(pB0,8),PKW(pB0,10),PKW(pB0,12),PKW(pB0,14)};pw2=(u32x4){PKW(pB1,0),PKW(pB1,2),PKW(pB1,4),PKW(pB1,6)};pw3=(u32x4){PKW(pB1,8),PKW(pB1,10),PKW(pB1,12),PKW(pB1,14)};
    SBAR(); pv(o,vb0+sl_cur,PAF(0),PAF(1),PAF(2),PAF(3)); }
  #undef PKW
  #undef PAF
  #undef VFR
  #undef PIN
  #undef MX3
  #undef GAPA
  #undef GAPB
  #undef EX
  #undef VRD
  #undef KRD
  #undef STEP
  #undef ENDW
  {auto rr=__builtin_amdgcn_permlane32_swap(__float_as_uint(l_reg),__float_as_uint(l_reg),false,false);l_reg=__uint_as_float(rr[0])+__uint_as_float(rr[1]);}
  if(hi==0)wsf[32+r32]=l_reg;asm volatile("s_waitcnt lgkmcnt(0)":::"memory");
  float rli[16];
  #pragma unroll
  for(int r=0;r<16;++r)rli[r]=__builtin_amdgcn_rcpf(wsf[32+crow(r,hi)]);
  bf16*Ow=O+(rowbase+q0+wid*QBLK)*OP+h*D;
  { bf16*stg=(bf16*)(shm+LDS_OST)+wid*2048;
    #pragma unroll
    for(int r=0;r<16;++r){const int orow=crow(r,hi);
      #pragma unroll
      for(int d0=0;d0<2;++d0)stg[orow*64+d0*32+r32]=__float2bfloat16(o[d0][r]*rli[r]);}
    asm volatile("s_waitcnt lgkmcnt(0)":::"memory");
    #pragma unroll
    for(int i=0;i<4;++i){const int row=i*8+(lane>>3),ch=lane&7; const u32x4 v=*(const u32x4*)(stg+row*64+ch*8); ATTN_STORE16(Ow+(long)row*OP+ch*8,v);} }
  asm volatile("s_waitcnt lgkmcnt(0)\n\ts_barrier":::"memory");
  #undef DMA_K
  #undef DMA_V
  #undef CMASK
  #undef START
  #undef RESC
  #undef ROT
}
constexpr int ATTN_LDS_BYTES=LDS_BYTES;
struct AttnTensors { const bf16* Q; const bf16* K; const bf16* V; bf16* O; };
struct AttnUnit { int b; int h; int qb; };
struct StaticOrder {
  int vcu;
  __device__ __forceinline__ explicit StaticOrder(int vcu_):vcu(vcu_){}
  __device__ __forceinline__ bool next(int i,AttnUnit&u)const{ if(i>=2)return false; const int pr=vcu>>5, lc=vcu&31; u.b=pr>>1; u.h=(pr&1)*4+(lc>>3); u.qb=(lc&7)*2+i; return true; }
};
template<int THRL=8> __device__ __forceinline__ void attn_phase(char*lds,const AttnTensors&T,const StaticOrder&S){
  AttnUnit u;
  for(int i=0;S.next(i,u);++i){ attn_unit<THRL>(u.b,u.h,u.qb,T.Q,T.K,T.V,T.O,lds); }
}
#undef SBAR
#undef WAIT_BAR
}
#define GAS __attribute__((address_space(1)))
#define LAS __attribute__((address_space(3)))
typedef unsigned short bf16;
typedef unsigned v4u __attribute__((ext_vector_type(4)));
typedef float f32x4 __attribute__((ext_vector_type(4)));
typedef short bf16x8 __attribute__((ext_vector_type(8)));
typedef GAS unsigned gu32;
typedef GAS unsigned long long gu64;
#define RLX_AGENT __ATOMIC_RELAXED, __HIP_MEMORY_SCOPE_AGENT
#define LDS_WAIT() asm volatile("s_waitcnt lgkmcnt(0)" ::: "memory")
#define VM_WAIT() asm volatile("s_waitcnt vmcnt(0)" ::: "memory")
__device__ __forceinline__ unsigned long long rt() { return __builtin_amdgcn_s_memrealtime(); }
__device__ __forceinline__ unsigned pk2(float lo, float hi) { return f2bf(lo) | (f2bf(hi) << 16); }

#define XB_TMO      128
#define XB_XCNT(j)  (256  + 64 * (j))
#define XB_XSUB(j)  (1280 + 64 * (j))
#define XB_XGEN(j)  (2304 + 64 * (j))
#define XB_TOP      3328
#define XB_TOPGEN   3392
#define XCD_BAR_WORDS 3456
#define XB_SPIN_CAP (1u << 18)

__device__ __forceinline__ unsigned xb_ld(unsigned* p)              { return __hip_atomic_load(p, __ATOMIC_RELAXED, __HIP_MEMORY_SCOPE_AGENT); }
__device__ __forceinline__ unsigned xb_add(unsigned* p, unsigned v) { return __hip_atomic_fetch_add(p, v, __ATOMIC_RELAXED, __HIP_MEMORY_SCOPE_AGENT); }
__device__ __forceinline__ unsigned xb_xcc_id() { return (unsigned)__builtin_amdgcn_s_getreg((3 << 11) | 20) & 0xFu; }
#define XB_SPIN(cond, bar) do { unsigned _sp = 0; while (cond) { __builtin_amdgcn_s_sleep(1); \
    if ((++_sp & 255u) == 0u) { if (xb_ld(&(bar)[XB_TMO])) break; if (_sp > XB_SPIN_CAP) { atomicAdd(&(bar)[XB_TMO], 1u); break; } } } } while (0)

struct XcdBarrier {
    unsigned* bar; unsigned x;
    volatile LAS unsigned* st;
};

__device__ __forceinline__ XcdBarrier xcd_barrier_post(unsigned* bar, volatile LAS unsigned* st) {
    XcdBarrier b; b.bar = bar; b.x = xb_xcc_id(); b.st = st;
    if (threadIdx.x == 0) (void)xb_add(&bar[XB_XCNT(b.x)], 1u);
    return b;
}
__device__ __forceinline__ void xcd_barrier_complete(unsigned* bar, unsigned x, unsigned& nloc, unsigned& nx) {
    const unsigned G = gridDim.x * gridDim.y * gridDim.z;
    unsigned sum, cnt, mine, sp = 0u;
    for (;;) {
        sum = 0u; cnt = 0u; mine = 0u;
#pragma unroll
        for (unsigned j = 0; j < 16; ++j) { const unsigned c = xb_ld(&bar[XB_XCNT(j)]); sum += c; cnt += (c > 0u) ? 1u : 0u; mine = (j == x) ? c : mine; }
        if (sum == G) break;
        __builtin_amdgcn_s_sleep(1);
        if ((++sp & 255u) == 0u) { if (xb_ld(&bar[XB_TMO])) break; if (sp > XB_SPIN_CAP) { atomicAdd(&bar[XB_TMO], 1u); break; } }
    }
    nloc = mine > 0u ? mine : 1u; nx = cnt > 0u ? cnt : 1u;
}

__device__ __forceinline__ void xcd_barrier(const XcdBarrier& b) {
    asm volatile("s_waitcnt vmcnt(0)" ::: "memory");
    __syncthreads();
    if (threadIdx.x == 0) {
        unsigned* bar = b.bar;
        __builtin_amdgcn_s_waitcnt(0);
        unsigned nloc = b.st[0], nx = b.st[1];
        if (nloc == 0u) { xcd_barrier_complete(bar, b.x, nloc, nx); b.st[0] = nloc; b.st[1] = nx; }
        const unsigned old = xb_add(&bar[XB_XSUB(b.x)], 1u);
        const unsigned gen = old / nloc;
        if (old + 1u == (gen + 1u) * nloc) {
            __builtin_amdgcn_fence(__ATOMIC_RELEASE, "agent");
            asm volatile("s_waitcnt vmcnt(0)" ::: "memory");
            const unsigned og = xb_add(&bar[XB_TOP], 1u);
            const unsigned tg = og / nx;
            if (og + 1u == (tg + 1u) * nx) xb_add(&bar[XB_TOPGEN], 1u);
            else XB_SPIN(xb_ld(&bar[XB_TOPGEN]) == tg, bar);
            __builtin_amdgcn_fence(__ATOMIC_ACQUIRE, "agent");
            xb_add(&bar[XB_XGEN(b.x)], 1u);
            asm volatile("s_waitcnt vmcnt(0)" ::: "memory");
        } else {
            XB_SPIN(xb_ld(&bar[XB_XGEN(b.x)]) == gen, bar);
            __builtin_amdgcn_fence(__ATOMIC_ACQUIRE, "agent");
            asm volatile("s_waitcnt vmcnt(0)" ::: "memory");
        }
    }
    __syncthreads();
}
constexpr int NWAVES = 8;
constexpr int RING_OFF = 0, RING_BYTES = 131072;
constexpr int LDSCTL_OFF = RING_BYTES, MISC_OFF = LDSCTL_OFF + 320;
constexpr int LDS_BYTES = 147456;
constexpr int CW_BAR = 4096;
static_assert((CW_BAR + 8 * XCD_BAR_WORDS) * 4 <= (int)CTL_ZERO_BYTES, "barrier regions inside the memset");

struct Frame {
    LAS unsigned char* lds;
    volatile LAS unsigned* MISC;
    gu32* ctl;
    int tid, lane, wave, vcu, G;
    const float* in[23]; float* out; unsigned char* ws;
};

__device__ __forceinline__ float wave_sum(float v) {
#pragma unroll
    for (int o = 1; o < 64; o <<= 1) v += __shfl_xor(v, o);
    return v;
}
namespace lru {
typedef float f32x2 __attribute__((ext_vector_type(2)));
constexpr int CH = 64, NCH = SEQ / CH;
constexpr int XCF_STRIDE = 68, XCB_STRIDE = 72;
constexpr int L_AU = 0, L_XCF = 65536, L_XCB = L_XCF + 64 * XCF_STRIDE * 4, L_SUB = L_XCB + 64 * XCB_STRIDE * 2, L_CAR = L_SUB + 4096, L_END = L_CAR + 4096;
static_assert(L_END <= RING_BYTES, "LRU scratch");
constexpr float LOG2E = 1.4426950408889634f;

__device__ __forceinline__ void pass1(Frame& F) {
    const int tid = F.tid, lane = F.lane, w = F.wave;
    LAS unsigned char* sh = F.lds + RING_OFF;
    LAS f32x2* AU = (LAS f32x2*)(sh + L_AU); LAS float* XCF = (LAS float*)(sh + L_XCF); LAS bf16* XCB = (LAS bf16*)(sh + L_XCB);
    LAS f32x2* SUB = (LAS f32x2*)(sh + L_SUB); LAS f32x2* CAR = (LAS f32x2*)(sh + L_CAR);
    unsigned char* ws = F.ws;
    const bf16* XR = (const bf16*)(ws + WS_XR); bf16* SL = (bf16*)(ws + WS_SL); bf16* PF = (bf16*)(ws + WS_PF); bf16* PB = (bf16*)(ws + WS_PBK);
    f32x2* AGG = (f32x2*)(ws + WS_AGG); const bf16* LW = (const bf16*)(ws + WS_LW);
    const int cu = F.vcu & 255, b = cu >> 6, n = (cu >> 3) & 7, oct = cu & 7;
    const int cc = tid & 63, tq = tid >> 6;
    const float* cw = F.in[6];
    const float w0 = cw[n * 64 + cc], w1 = cw[512 + n * 64 + cc], w2 = cw[1024 + n * 64 + cc], w3 = cw[1536 + n * 64 + cc], cbv = F.in[7][n * 64 + cc];
    const int ge = w >> 2, gj = (w & 3) * 16 + (lane & 15), gq = lane >> 4, gc = ge * 512 + n * 64 + gj;
    const float bav = F.in[9][gc], bxv = F.in[11][gc];
    const float k8 = 8.0f * (-log1pf(expf(-F.in[12][gc]))) * LOG2E;
    bf16x8 bfr[2][2];
#pragma unroll
    for (int g = 0; g < 2; ++g)
#pragma unroll
        for (int ks = 0; ks < 2; ++ks) bfr[g][ks] = *(const bf16x8*)(LW + ((size_t)(n * 256 + ge * 128 + g * 64 + gj)) * 64 + ks * 32 + 8 * gq);
    const int sc = tid & 63, se = (tid >> 6) & 1, ssub = tid >> 7, scol = se * 64 + sc;
    for (int ci = 0; ci < 8; ++ci) {
        const int chunk = oct * 8 + ci, t0 = chunk * CH; const size_t row0 = (size_t)b * SEQ + t0;
        __syncthreads();
        {
            float xv[11];
#pragma unroll
            for (int r = 0; r < 11; ++r) { const int tt = t0 + tq * 8 - 2 + r; xv[r] = (tt >= 0 && tt < SEQ) ? bf2f(XR[((size_t)b * SEQ + tt) * DLRU + n * 64 + cc]) : 0.f; }
#pragma unroll
            for (int i = 0; i < 8; ++i) { const float xc = cbv + w0 * xv[i] + w1 * xv[i + 1] + w2 * xv[i + 2] + w3 * xv[i + 3]; const int t = tq * 8 + i;
                XCF[t * XCF_STRIDE + cc] = xc; XCB[t * XCB_STRIDE + cc] = (bf16)f2bf(xc); }
        }
        __syncthreads();
#pragma unroll
        for (int mb = 0; mb < 4; ++mb) {
            const LAS bf16* ap = XCB + (16 * mb + (lane & 15)) * XCB_STRIDE + 8 * gq;
            const bf16x8 a0 = *(const LAS bf16x8*)(ap), a1 = *(const LAS bf16x8*)(ap + 32);
            f32x4 ga = {0.f, 0.f, 0.f, 0.f}, gx = {0.f, 0.f, 0.f, 0.f};
            ga = __builtin_amdgcn_mfma_f32_16x16x32_bf16(a0, bfr[0][0], ga, 0, 0, 0); ga = __builtin_amdgcn_mfma_f32_16x16x32_bf16(a1, bfr[0][1], ga, 0, 0, 0);
            gx = __builtin_amdgcn_mfma_f32_16x16x32_bf16(a0, bfr[1][0], gx, 0, 0, 0); gx = __builtin_amdgcn_mfma_f32_16x16x32_bf16(a1, bfr[1][1], gx, 0, 0, 0);
#pragma unroll
            for (int r = 0; r < 4; ++r) {
                const int t = 16 * mb + 4 * gq + r; const float xc = XCF[t * XCF_STRIDE + gj];
                const float rg = __builtin_amdgcn_rcpf(1.0f + __builtin_amdgcn_exp2f(-LOG2E * (ga[r] + bav)));
                const float ig = __builtin_amdgcn_rcpf(1.0f + __builtin_amdgcn_exp2f(-LOG2E * (gx[r] + bxv)));
                const float a = __builtin_amdgcn_exp2f(k8 * rg);
                const float u = __builtin_amdgcn_sqrtf(fmaxf(fmaf(-a, a, 1.0f), 0.f)) * (ig * xc);
                AU[t * 128 + ge * 64 + gj] = (f32x2){a, u};
            }
        }
        __syncthreads();
        {
            float P = 1.f, h = 0.f;
#pragma unroll
            for (int i = 0; i < 16; ++i) { const int t = se == 0 ? 16 * ssub + i : 16 * ssub + 15 - i; const f32x2 au = AU[t * 128 + scol]; h = au.x * h + au.y; P *= au.x; AU[t * 128 + scol] = (f32x2){P, h}; }
            SUB[ssub * 128 + scol] = (f32x2){P, h};
        }
        __syncthreads();
        {
            float cin = 0.f, pin = 1.f;
            if (se == 0) { for (int s2 = 0; s2 < ssub; ++s2) { const f32x2 ph = SUB[s2 * 128 + scol]; cin = ph.x * cin + ph.y; pin *= ph.x; } }
            else { for (int s2 = 3; s2 > ssub; --s2) { const f32x2 ph = SUB[s2 * 128 + scol]; cin = ph.x * cin + ph.y; pin *= ph.x; } }
            CAR[ssub * 128 + scol] = (f32x2){pin, cin};
            if ((se == 0 && ssub == 3) || (se == 1 && ssub == 0)) { const f32x2 ph = SUB[ssub * 128 + scol];
                AGG[((size_t)(b * NCH + chunk) * 2 + se) * DLRU + n * 64 + sc] = (f32x2){pin * ph.x, ph.y + ph.x * cin}; }
        }
        __syncthreads();
        {
            const int cp = tid & 31;
#pragma unroll
            for (int ps = 0; ps < 4; ++ps) {
                const int t = ps * 16 + (tid >> 5), sub = t >> 4;
                const f32x4 f = *(const LAS f32x4*)(AU + t * 128 + 2 * cp), bk = *(const LAS f32x4*)(AU + t * 128 + 64 + 2 * cp);
                const f32x4 cf = *(const LAS f32x4*)(CAR + sub * 128 + 2 * cp), cb = *(const LAS f32x4*)(CAR + sub * 128 + 64 + 2 * cp);
                const float hf0 = f[1] + f[0] * cf[1], hf1 = f[3] + f[2] * cf[3], pf0 = f[0] * cf[0], pf1 = f[2] * cf[2];
                const float hb0 = bk[1] + bk[0] * cb[1], hb1 = bk[3] + bk[2] * cb[3], pb0 = bk[0] * cb[0], pb1 = bk[2] * cb[2];
                const size_t o = (row0 + t) * DLRU + n * 64 + 2 * cp;
                *(unsigned*)(SL + o) = pk2(hf0 + hb0, hf1 + hb1); *(unsigned*)(PF + o) = pk2(pf0, pf1); *(unsigned*)(PB + o) = pk2(pb0, pb1);
            }
        }
    }
    __syncthreads();
}

__device__ __forceinline__ f32x4 lo4(const v4u w) { f32x4 v; v[0] = __uint_as_float(w.x << 16); v[1] = __uint_as_float(w.x & 0xffff0000u); v[2] = __uint_as_float(w.y << 16); v[3] = __uint_as_float(w.y & 0xffff0000u); return v; }
__device__ __forceinline__ f32x4 hi4(const v4u w) { f32x4 v; v[0] = __uint_as_float(w.z << 16); v[1] = __uint_as_float(w.z & 0xffff0000u); v[2] = __uint_as_float(w.w << 16); v[3] = __uint_as_float(w.w & 0xffff0000u); return v; }
__device__ __forceinline__ float sum8sq(const f32x4 a, const f32x4 b) { return ((a[0] * a[0] + a[1] * a[1]) + (a[2] * a[2] + a[3] * a[3])) + ((b[0] * b[0] + b[1] * b[1]) + (b[2] * b[2] + b[3] * b[3])); }
__device__ __forceinline__ v4u pack8(const f32x4 a, const f32x4 b) { v4u o; o.x = pk2(a[0], a[1]); o.y = pk2(a[2], a[3]); o.z = pk2(b[0], b[1]); o.w = pk2(b[2], b[3]); return o; }

__device__ __forceinline__ void pass2(Frame& F) {
    const int tid = F.tid;
    LAS unsigned char* sh = F.lds + RING_OFF;
    LAS f32x2* CFB = (LAS f32x2*)sh;
    unsigned char* ws = F.ws;
    const bf16* SL = (const bf16*)(ws + WS_SL); const bf16* PF = (const bf16*)(ws + WS_PF); const bf16* PB = (const bf16*)(ws + WS_PBK); const bf16* XG = (const bf16*)(ws + WS_XG);
    bf16* Y = (bf16*)(ws + WS_Y); const f32x2* AGG = (const f32x2*)(ws + WS_AGG);
    const float* gat = F.in[13]; const float* gl = F.in[14];
    const int cu = F.vcu & 255, b = cu >> 6, chunk = cu & 63; const size_t row0 = (size_t)b * SEQ + chunk * CH;
    {
        float cf = 0.f, cb = 0.f;
        for (int k = 0; k < chunk; ++k) { const f32x2 ah = AGG[((size_t)(b * NCH + k) * 2 + 0) * DLRU + tid]; cf = ah.x * cf + ah.y; }
        for (int k = NCH - 1; k > chunk; --k) { const f32x2 ah = AGG[((size_t)(b * NCH + k) * 2 + 1) * DLRU + tid]; cb = ah.x * cb + ah.y; }
        CFB[tid] = (f32x2){cf, cb};
    }
    __syncthreads();
    const int t = tid >> 3, l8 = tid & 7; const size_t row = row0 + t;
    {
        f32x4 y[8][2]; float s = 0.f;
#pragma unroll
        for (int k = 0; k < 8; ++k) {
            const int c0 = (l8 + 8 * k) * 8; const size_t o = row * DLRU + c0;
            const v4u sl = *(const GAS v4u*)(SL + o), pf = *(const GAS v4u*)(PF + o), pb = *(const GAS v4u*)(PB + o), xg = *(const GAS v4u*)(XG + o);
            const f32x4 c01 = *(const LAS f32x4*)(CFB + c0), c23 = *(const LAS f32x4*)(CFB + c0 + 2), c45 = *(const LAS f32x4*)(CFB + c0 + 4), c67 = *(const LAS f32x4*)(CFB + c0 + 6);
            const f32x4 cfl = {c01[0], c01[2], c23[0], c23[2]}, cbl = {c01[1], c01[3], c23[1], c23[3]}, cfh = {c45[0], c45[2], c67[0], c67[2]}, cbh = {c45[1], c45[3], c67[1], c67[3]};
            y[k][0] = (lo4(sl) + lo4(pf) * cfl + lo4(pb) * cbl) * lo4(xg); y[k][1] = (hi4(sl) + hi4(pf) * cfh + hi4(pb) * cbh) * hi4(xg);
            s += sum8sq(y[k][0], y[k][1]);
        }
        s += __shfl_xor(s, 1); s += __shfl_xor(s, 2); s += __shfl_xor(s, 4);
        const float rn = rsqrtf(s * (1.0f / DLRU) + EPS);
#pragma unroll
        for (int k = 0; k < 8; ++k) {
            const int c0 = (l8 + 8 * k) * 8; const f32x4 g0 = *(const f32x4*)(gl + c0), g1 = *(const f32x4*)(gl + c0 + 4);
            *(GAS v4u*)(Y + row * DM + DATT + c0) = pack8(y[k][0] * rn * g0, y[k][1] * rn * g1);
        }
    }
    {
        f32x4 y[8][2]; float s = 0.f;
#pragma unroll
        for (int k = 0; k < 8; ++k) { const int c0 = (l8 + 8 * k) * 8; const v4u v = *(const GAS v4u*)(Y + row * DM + c0); y[k][0] = lo4(v); y[k][1] = hi4(v); s += sum8sq(y[k][0], y[k][1]); }
        s += __shfl_xor(s, 1); s += __shfl_xor(s, 2); s += __shfl_xor(s, 4);
        const float rn = rsqrtf(s * (1.0f / DATT) + EPS);
#pragma unroll
        for (int k = 0; k < 8; ++k) {
            const int c0 = (l8 + 8 * k) * 8; const f32x4 g0 = *(const f32x4*)(gat + c0), g1 = *(const f32x4*)(gat + c0 + 4);
            *(GAS v4u*)(Y + row * DM + c0) = pack8(y[k][0] * rn * g0, y[k][1] * rn * g1);
        }
    }
    __syncthreads();
}
}

__device__ __forceinline__ int win_rowmap(int L) {
    const int tile = L >> 8, l = L & 255; int p;
    if (tile < 3) p = (((l >> 5) & 1) << 7) | ((l >> 6) << 5) | (l & 31);
    else { const int lo = l & 31; p = (l & ~31) | (((lo >> 2) & 1) << 4) | ((lo >> 3) << 2) | (lo & 3); }
    return tile * 256 + p;
}
template <bool MAP>
__device__ __forceinline__ void p0_transpose_item(const float* W, int K, int N, bf16* WT, const float* g, LAS float* scr, int item, int lane) {
    const int nblk = N / 32, kb = item / nblk, nb = item % nblk, k0 = 64 * kb, n0 = 32 * nb;
#pragma unroll 8
    for (int i = 0; i < 32; ++i) { const int kk = 2 * i + (lane >> 5); float v = W[(size_t)(k0 + kk) * N + n0 + (lane & 31)]; if (g) v *= g[k0 + kk]; scr[kk * 33 + (lane & 31)] = v; }
    LDS_WAIT(); asm volatile("" ::: "memory");
    const int c = lane & 7;
#pragma unroll
    for (int j = 0; j < 4; ++j) { const int n = (lane >> 3) + 8 * j; const LAS float* s = scr + (8 * c) * 33 + n;
        v4u o; o.x = pk2(s[0 * 33], s[1 * 33]); o.y = pk2(s[2 * 33], s[3 * 33]); o.z = pk2(s[4 * 33], s[5 * 33]); o.w = pk2(s[6 * 33], s[7 * 33]);
        const int row = MAP ? win_rowmap(n0 + n) : (n0 + n);
        *(GAS v4u*)(WT + (size_t)row * K + k0 + 8 * c) = o; }
    LDS_WAIT(); asm volatile("" ::: "memory");
}
__device__ __forceinline__ void p0_prologue(Frame& F) {
    LAS float* scr = (LAS float*)(F.lds + RING_OFF + F.wave * 16384);
    const int gw = F.vcu * NWAVES + F.wave, NGW = F.G * NWAVES;
    constexpr int I_IN = (DM / 64) * (DIN / 32), I_OUT = (DM / 64) * (DM / 32), I_UP = (DM / 64) * (DFF / 32), I_DN = (DFF / 64) * (DM / 32), I_G = I_OUT, I_P = (DPLE / 64) * (DM / 32);
    constexpr int NITEMS = I_IN + I_OUT + I_UP + I_DN + I_G + I_P;
    unsigned char* ws = F.ws;
    for (int it = gw; it < NITEMS; it += NGW) {
        int r = it;
        if (r < I_IN) { p0_transpose_item<true>(F.in[3], DM, DIN, (bf16*)(ws + WS_WIN), F.in[2], scr, r, F.lane); continue; } r -= I_IN;
        if (r < I_OUT) { p0_transpose_item<false>(F.in[15], DM, DM, (bf16*)(ws + WS_WOUT), nullptr, scr, r, F.lane); continue; } r -= I_OUT;
        if (r < I_UP) { p0_transpose_item<false>(F.in[17], DM, DFF, (bf16*)(ws + WS_WUP), F.in[16], scr, r, F.lane); continue; } r -= I_UP;
        if (r < I_DN) { p0_transpose_item<false>(F.in[18], DFF, DM, (bf16*)(ws + WS_WDOWN), nullptr, scr, r, F.lane); continue; } r -= I_DN;
        if (r < I_G) { p0_transpose_item<false>(F.in[20], DM, DM, (bf16*)(ws + WS_WG), F.in[19], scr, r, F.lane); continue; } r -= I_G;
        p0_transpose_item<false>(F.in[21], DPLE, DM, (bf16*)(ws + WS_WP), nullptr, scr, r, F.lane);
    }
    const float* x = F.in[0]; const float* p = F.in[1]; float* RSX = (float*)(ws + WS_RSX); bf16* XB = (bf16*)(ws + WS_HB); bf16* PB = (bf16*)(ws + WS_PB);
    for (int m = gw; m < T; m += NGW) {
        const GAS f32x4* xr = (const GAS f32x4*)(x + (size_t)m * DM) + F.lane;
        f32x4 v[4]; float s = 0.f;
#pragma unroll
        for (int j = 0; j < 4; ++j) { v[j] = xr[64 * j]; s += (v[j].x * v[j].x + v[j].y * v[j].y) + (v[j].z * v[j].z + v[j].w * v[j].w); }
        s = wave_sum(s);
        if (F.lane == 0) RSX[m] = rsqrtf(s * (1.0f / DM) + EPS);
        GAS unsigned long long* o8 = (GAS unsigned long long*)(XB + (size_t)m * DM) + F.lane;
#pragma unroll
        for (int j = 0; j < 4; ++j) o8[64 * j] = (unsigned long long)pk2(v[j].x, v[j].y) | ((unsigned long long)pk2(v[j].z, v[j].w) << 32);
        const f32x4 pv = *((const GAS f32x4*)(p + (size_t)m * DPLE) + F.lane);
        *((GAS unsigned long long*)(PB + (size_t)m * DPLE) + F.lane) = (unsigned long long)pk2(pv.x, pv.y) | ((unsigned long long)pk2(pv.z, pv.w) << 32);
    }
    { bf16* LW = (bf16*)(ws + WS_LW);
      for (int idx = (F.vcu * NWAVES + F.wave) * 64 + F.lane; idx < NBLK * 256 * 64; idx += F.G * NWAVES * 64) {
          const int n = idx >> 14, col = (idx >> 6) & 255, k = idx & 63, e = col >> 7, gsel = (col >> 6) & 1, j = col & 63;
          const float* src = gsel ? F.in[10] : F.in[8]; LW[idx] = (bf16)f2bf(src[(((size_t)e * NBLK + n) * 64 + k) * 64 + j]); } }
    float* rope = (float*)(ws + WS_ROPE);
    for (int idx = (F.vcu * NWAVES + F.wave) * 64 + F.lane; idx < 1024; idx += F.G * NWAVES * 64) {
        const int pos = idx >> 4, i = idx & 15; const float fr = powf(10000.f, -(float)i / 16.f); const float ang = (float)pos * fr;
        rope[idx] = cosf(ang); rope[1024 + idx] = sinf(ang);
    }
}

#ifndef PHC
#define PHC 0x1ff
#endif
struct Args { const float* in[23]; float* out; unsigned char* ws; int ph_lo, ph_hi, li, flags; };
constexpr int NPHASE = 9;
__global__ void __launch_bounds__(NWAVES * 64, 2) mega(Args args) {
    extern __shared__ __attribute__((aligned(16))) unsigned char lds[];
    Frame F;
    F.lds = (LAS unsigned char*)lds;
    F.MISC = (volatile LAS unsigned*)(F.lds + MISC_OFF);
    F.tid = threadIdx.x; F.lane = F.tid & 63; F.wave = __builtin_amdgcn_readfirstlane(F.tid >> 6);
    F.G = gridDim.x; { const int bx = blockIdx.x; F.vcu = (F.G % 8 == 0) ? (bx % 8) * (F.G / 8) + bx / 8 : bx; }
    unsigned char* ws = args.ws; F.ws = ws; F.out = args.out;
#pragma unroll
    for (int i = 0; i < 23; ++i) F.in[i] = args.in[i];
    F.ctl = (gu32*)(ws + WS_CTL);
    for (int u = F.tid; u < (LDS_BYTES - LDSCTL_OFF) / 4; u += NWAVES * 64) ((LAS unsigned*)(F.lds + LDSCTL_OFF))[u] = 0u;
    __syncthreads();
    const int lo = args.ph_lo, hi = args.ph_hi;
    XcdBarrier bar; bar.bar = (unsigned*)(F.ctl + CW_BAR) + args.li * XCD_BAR_WORDS; bar.x = 0; bar.st = nullptr;
    if (hi - lo > 1) bar = xcd_barrier_post((unsigned*)(F.ctl + CW_BAR) + args.li * XCD_BAR_WORDS, F.MISC + 8);
#define GRID_BAR() xcd_barrier(bar)
#define IN(k) (lo <= (k) && (k) < hi)
#define BOTH(k) (IN(k) && IN((k) + 1))
    bf16* const XB = (bf16*)(ws + WS_HB); bf16* const HB = (bf16*)(ws + WS_HB); bf16* const PB = (bf16*)(ws + WS_PB); bf16* const PP = (bf16*)(ws + WS_PP);
    bf16* const Qb = (bf16*)(ws + WS_Q); bf16* const Kb = (bf16*)(ws + WS_K); bf16* const Vb = (bf16*)(ws + WS_V); bf16* const XR = (bf16*)(ws + WS_XR); bf16* const XG = (bf16*)(ws + WS_XG);
    bf16* const Y = (bf16*)(ws + WS_Y); bf16* const Mb = (bf16*)(ws + WS_M);
    float* const RSX = (float*)(ws + WS_RSX); float* const ROPE = (float*)(ws + WS_ROPE);
    float* const SS1 = (float*)(ws + WS_SS1); float* const SS2 = (float*)(ws + WS_SS2); float* const SS3 = (float*)(ws + WS_SS3);

    if ((PHC >> 0 & 1) && IN(0)) { p0_prologue(F); if (BOTH(0)) GRID_BAR(); }

    if ((PHC >> 1 & 1) && IN(1)) {
        { pg8::Gemm g{XB, (const bf16*)(ws + WS_WIN), T, DIN, DM}; pg8::StaticOrder S; S.init(T, DIN, F.G, (int)blockIdx.x);
          pg8::EpiIn E{RSX, F.in[4], F.in[5], ROPE, Qb, Kb, Vb, XR, XG};
          pg8::gemm_phase<pg8::EpiIn, pg8::StaticOrder, PG8_ALIGN, PG8_SP2>(F.lds + RING_OFF, g, S, E); }
        if (BOTH(1)) GRID_BAR();
    }

    if ((PHC >> 2 & 1) && IN(2)) {
        if (args.flags & 1) {
            const attn_body::AttnTensors AT{(const attn_body::bf16*)Qb, (const attn_body::bf16*)Kb, (const attn_body::bf16*)Vb, (attn_body::bf16*)Y};
            const attn_body::StaticOrder S(F.vcu);
            attn_body::attn_phase<8>((char*)lds + RING_OFF, AT, S);
        }
        if (args.flags & 2) lru::pass1(F);
        if (BOTH(2)) GRID_BAR();
    }
    if ((PHC >> 3 & 1) && IN(3)) {
        if (args.flags & 4) lru::pass2(F);
        { pg8::Gemm g{PB, (const bf16*)(ws + WS_WP), T, DM, DPLE}; pg8::StaticOrder S; S.init(T, DM, F.G, (int)blockIdx.x);
          pg8::EpiBf16<0> E{PP, DM, nullptr, 0, 0, 1.f};
          pg8::gemm_phase<pg8::EpiBf16<0>, pg8::StaticOrder, PG8_ALIGN, PG8_SP2>(F.lds + RING_OFF, g, S, E); }
        if (BOTH(3)) GRID_BAR();
    }
    if ((PHC >> 4 & 1) && IN(4)) {
        pg8::Gemm g{Y, (const bf16*)(ws + WS_WOUT), T, DM, DM}; pg8::StaticOrder S; S.init(T, DM, F.G, (int)blockIdx.x);
        pg8::EpiRes E{F.in[0], F.out, HB, SS1};
        pg8::gemm_phase<pg8::EpiRes, pg8::StaticOrder, PG8_ALIGN, PG8_SP2>(F.lds + RING_OFF, g, S, E);
        if (BOTH(4)) GRID_BAR();
    }
    if ((PHC >> 5 & 1) && IN(5)) {
        pg8::Gemm g{HB, (const bf16*)(ws + WS_WUP), T, DFF, DM}; pg8::StaticOrder S; S.init(T, DFF, F.G, (int)blockIdx.x);
        pg8::EpiUp E{SS1, Mb};
        pg8::gemm_phase<pg8::EpiUp, pg8::StaticOrder, PG8_ALIGN, PG8_SP2>(F.lds + RING_OFF, g, S, E);
        if (BOTH(5)) GRID_BAR();
    }
    if ((PHC >> 6 & 1) && IN(6)) {
        pg8::Gemm g{Mb, (const bf16*)(ws + WS_WDOWN), T, DM, DFF}; pg8::StaticOrder S; S.init(T, DM, F.G, (int)blockIdx.x);
        pg8::EpiRes E{F.out, F.out, HB, SS2};
        pg8::gemm_phase<pg8::EpiRes, pg8::StaticOrder, PG8_ALIGN, PG8_SP2>(F.lds + RING_OFF, g, S, E);
        if (BOTH(6)) GRID_BAR();
    }
    if ((PHC >> 7 & 1) && IN(7)) {
        pg8::Gemm g{HB, (const bf16*)(ws + WS_WG), T, DM, DM}; pg8::StaticOrder S; S.init(T, DM, F.G, (int)blockIdx.x);
        pg8::EpiGate E{SS2, PP, F.out, SS3};
        pg8::gemm_phase<pg8::EpiGate, pg8::StaticOrder, PG8_ALIGN, PG8_SP2>(F.lds + RING_OFF, g, S, E);
        if (BOTH(7)) GRID_BAR();
    }
    if ((PHC >> 8 & 1) && IN(8)) {
        const int gw = F.vcu * NWAVES + F.wave, NGW = F.G * NWAVES; const float* gf = F.in[22];
        for (int m = gw; m < T; m += NGW) {
            const float rs = pg8::rstd16(SS3 + (size_t)m * 16);
            GAS f32x4* o = (GAS f32x4*)(F.out + (size_t)m * DM) + F.lane;
#pragma unroll
            for (int j = 0; j < 4; ++j) { const f32x4 gv = *((const GAS f32x4*)gf + F.lane + 64 * j); f32x4 v = o[64 * j]; v = v * rs * gv; o[64 * j] = v; }
        }
    }
#undef IN
#undef BOTH
#undef GRID_BAR
}

#ifndef MEGA_MASK
#define MEGA_MASK 0x01
#endif
extern "C" void kernel_launch(void* const* d_in, const int* in_sizes, int n_in, void* d_out, int out_size, void* d_ws, size_t ws_size, hipStream_t stream) {
    static int grid = 0;
    if (grid == 0) {
        if (n_in != 23 || in_sizes[0] != T * DM || out_size != T * DM || ws_size < WS_END) { fprintf(stderr, "kernel_launch: unexpected shapes (n_in %d, in0 %d, out %d, ws %zu)\n", n_in, n_in > 0 ? in_sizes[0] : -1, out_size, ws_size); grid = -1; return; }
        int dev = 0, cus = 0, per_cu = 0;
        if (hipGetDevice(&dev) != hipSuccess || hipDeviceGetAttribute(&cus, hipDeviceAttributeMultiprocessorCount, dev) != hipSuccess) { grid = -1; return; }
        if (hipFuncSetAttribute((const void*)mega, hipFuncAttributeMaxDynamicSharedMemorySize, LDS_BYTES) != hipSuccess) { fprintf(stderr, "kernel_launch: hipFuncSetAttribute failed\n"); grid = -1; return; }
        if (hipOccupancyMaxActiveBlocksPerMultiprocessor(&per_cu, (const void*)mega, NWAVES * 64, LDS_BYTES) != hipSuccess || per_cu < 1) { fprintf(stderr, "kernel_launch: occupancy query says %d blocks per CU\n", per_cu); (void)hipGetLastError(); grid = -1; return; }
        grid = cus;
        if (grid != 256) fprintf(stderr, "kernel_launch: %d CUs; this kernel's unit maps assume 256\n", grid);
    }
    if (grid < 0) return;
    const float* in[23]; for (int i = 0; i < 23; ++i) in[i] = (const float*)d_in[i];
    unsigned char* ws = (unsigned char*)d_ws; float* out = (float*)d_out;
    (void)hipMemsetAsync(ws + WS_CTL, 0, CTL_ZERO_BYTES, stream);
    Args a{}; for (int i = 0; i < 23; ++i) a.in[i] = in[i]; a.out = out; a.ws = ws;
    int li = 0;
    auto launch = [&](int lo, int hi, int flags) {
        a.ph_lo = lo; a.ph_hi = hi; a.li = li++; a.flags = flags;
        if (hi - lo > 1) { void* kargs[] = {(void*)&a}; hipError_t e = hipLaunchCooperativeKernel((const void*)mega, dim3(grid), dim3(NWAVES * 64), kargs, LDS_BYTES, stream);
            if (e != hipSuccess) fprintf(stderr, "kernel_launch: cooperative launch failed: %s\n", hipGetErrorString(e)); }
        else hipLaunchKernelGGL(mega, dim3(grid), dim3(NWAVES * 64), LDS_BYTES, stream, a);
    };
    constexpr int MM = MEGA_MASK;
    if (MM == 0x7f) { launch(0, NPHASE, 7); return; }
    bf16_t* Q = (bf16_t*)(ws + WS_Q); bf16_t* K = (bf16_t*)(ws + WS_K); bf16_t* V = (bf16_t*)(ws + WS_V); bf16_t* XR = (bf16_t*)(ws + WS_XR); bf16_t* XG = (bf16_t*)(ws + WS_XG);
    bf16_t* Y = (bf16_t*)(ws + WS_Y); bf16_t* M = (bf16_t*)(ws + WS_M);
    float* HF = out; float* HBs = out + (size_t)T * DLRU;
    if (MM & 0x01) launch(0, 2, 0); else nv::s1<<<T / 4, 256, 0, stream>>>(in[0], in[2], in[3], in[4], in[5], Q, K, V, XR, XG);
    if (MM & 0x02) launch(2, 3, 1); else nv::attn<<<dim3(SEQ / 128, NQH, BATCH), 128, 0, stream>>>(Q, K, V, Y);
    if (MM & 0x04) { launch(2, 3, 2); launch(3, 4, 4); }
    else { nv::lru<<<BATCH * NBLK, 128, 0, stream>>>(XR, in[6], in[7], in[8], in[9], in[10], in[11], in[12], HF, HBs); nv::merge<<<T, 256, 0, stream>>>(Y, HF, HBs, XG, in[13], in[14]);
           if (MM & 0x40) launch(3, 4, 0); }
    if (MM & 0x08) launch(4, 5, 0); else nv::s4<<<T / 4, 256, 0, stream>>>(in[0], Y, in[15], out);
    if (MM & 0x10) launch(5, 6, 0); else nv::s5<<<T / 4, 256, 0, stream>>>(out, in[16], in[17], M);
    if (MM & 0x20) launch(6, 7, 0); else nv::s6<<<T / 4, 256, 0, stream>>>(out, M, in[18]);
    if (MM & 0x40) launch(7, 9, 0); else nv::s7<<<T / 4, 256, 0, stream>>>(out, in[1], in[19], in[20], in[21], in[22]);
}
```

```cpp
#include <hip/hip_runtime.h>
#include <cstdio>
#include <cstdint>

constexpr int BATCH = 4, SEQ = 4096, DM = 1024, T = BATCH * SEQ;
constexpr int DATT = 512, NQH = 8, NKVH = 2, HD = 64, DKV = 128, DLRU = 512, NBLK = 8, BW = 64;
constexpr int DIN = 1792, DFF = 4096, DPLE = 256, GRIDW = 64;
constexpr float EPS = 1e-6f;
constexpr float C2 = 0.125f * 1.4426950408889634f;

typedef unsigned short bf16_t;
__device__ __forceinline__ unsigned f2bf(float f) { unsigned u = __float_as_uint(f); return (u + 0x7fffu + ((u >> 16) & 1u)) >> 16; }
__device__ __forceinline__ float bf2f(bf16_t h) { return __uint_as_float(((unsigned)h) << 16); }

constexpr size_t MiB = 1u << 20, KiB = 1u << 10;
constexpr size_t WS_CTL = 0, CTL_ZERO_BYTES = 128 * KiB;
constexpr size_t WS_ROPE = 1 * MiB;
constexpr size_t WS_RSX = 1 * MiB + 64 * KiB;
constexpr size_t WS_LW = 1 * MiB + 512 * KiB;
constexpr size_t WS_SS1 = 2 * MiB, WS_SS2 = 3 * MiB, WS_SS3 = 4 * MiB;
constexpr size_t WS_AGG = 5 * MiB;
constexpr size_t WS_WIN = 7 * MiB;
constexpr size_t WS_WOUT = WS_WIN + 3584 * KiB;
constexpr size_t WS_WUP = WS_WOUT + 2 * MiB;
constexpr size_t WS_WDOWN = WS_WUP + 8 * MiB;
constexpr size_t WS_WG = WS_WDOWN + 8 * MiB;
constexpr size_t WS_WP = WS_WG + 2 * MiB;
static_assert(WS_WP + 512 * KiB <= 32 * MiB, "weights");
constexpr size_t WS_PP = 32 * MiB;
constexpr size_t WS_HB = 64 * MiB;
constexpr size_t WS_PB = 96 * MiB;
constexpr size_t WS_H3B = 96 * MiB;
constexpr size_t WS_K = 104 * MiB;
constexpr size_t WS_V = 108 * MiB;
constexpr size_t WS_Q = 112 * MiB;
constexpr size_t WS_M = 128 * MiB;
constexpr size_t WS_XR = 128 * MiB;
constexpr size_t WS_XG = 144 * MiB;
constexpr size_t WS_Y = 160 * MiB;
constexpr size_t WS_SL = 192 * MiB;
constexpr size_t WS_PF = 208 * MiB;
constexpr size_t WS_PBK = 224 * MiB;
constexpr size_t WS_END = 256 * MiB;

#define MEGA_MASK 0x7f
#define REP 0
namespace nv {
__device__ __forceinline__ float block_sum(float v, float* red) {
    for (int o = 32; o > 0; o >>= 1) v += __shfl_xor(v, o);
    __syncthreads();
    if ((threadIdx.x & 63) == 0) red[threadIdx.x >> 6] = v;
    __syncthreads();
    const int nw = blockDim.x >> 6; float s = 0.f;
    for (int i = 0; i < nw; ++i) s += red[i];
    return s;
}
__device__ __forceinline__ float gelu_tanh(float x) { const float u = 0.7978845608028654f * (x + 0.044715f * x * x * x); return 0.5f * x * (1.f + tanhf(u)); }
__device__ __forceinline__ float sigmoidf(float x) { return 1.f / (1.f + expf(-x)); }

__device__ __forceinline__ void dot4(const float* As, int K, const float* __restrict__ W, int N, int col, float acc[4]) {
    for (int k = 0; k < K; ++k) { const float w = W[(size_t)k * N + col]; const float4 a = *(const float4*)(As + 4 * k);
        acc[0] += a.x * w; acc[1] += a.y * w; acc[2] += a.z * w; acc[3] += a.w * w; }
}

__global__ void __launch_bounds__(256) s1(const float* __restrict__ x, const float* __restrict__ g, const float* __restrict__ w_in, const float* __restrict__ qn, const float* __restrict__ kn,
                                          bf16_t* Q, bf16_t* K, bf16_t* V, bf16_t* XR, bf16_t* XG) {
    __shared__ float As[DM * 4]; __shared__ float zs[4][DIN]; __shared__ float red[4]; __shared__ float rs[4];
    const int tid = threadIdx.x, t0 = blockIdx.x * 4;
    for (int r = 0; r < 4; ++r) { float s = 0.f; for (int i = tid; i < DM; i += 256) { const float v = x[(size_t)(t0 + r) * DM + i]; s += v * v; }
        s = block_sum(s, red); if (tid == 0) rs[r] = rsqrtf(s / DM + EPS); }
    __syncthreads();
    for (int i = tid; i < DM * 4; i += 256) { const int k = i >> 2, r = i & 3; As[i] = x[(size_t)(t0 + r) * DM + k] * rs[r] * g[k]; }
    __syncthreads();
    for (int j = 0; j < DIN / 256; ++j) { const int col = tid + 256 * j; float acc[4] = {0.f, 0.f, 0.f, 0.f}; dot4(As, DM, w_in, DIN, col, acc);
        for (int r = 0; r < 4; ++r) zs[r][col] = acc[r]; }
    __syncthreads();
    for (int it = tid; it < 4 * 10 * 16; it += 256) {
        const int i = it & 15, hh = (it >> 4) % 10, r = it / 160, t = t0 + r, pos = t % SEQ;
        const float* zh = &zs[r][hh < 8 ? hh * 64 : DATT + (hh - 8) * 64];
        float ss = 0.f; for (int d = 0; d < 64; ++d) ss += zh[d] * zh[d];
        const float rn = rsqrtf(ss / 64.f + EPS); const float* gn = hh < 8 ? qn : kn;
        const float fr = powf(10000.f, -(float)i / 16.f);
        const float ar = (float)(pos / GRIDW) * fr, ac = (float)(pos % GRIDW) * fr;
        const float cr = cosf(ar), sr = sinf(ar), cc = cosf(ac), sc = sinf(ac);
        const float x1 = zh[i] * rn * gn[i], x2 = zh[16 + i] * rn * gn[16 + i], x3 = zh[32 + i] * rn * gn[32 + i], x4 = zh[48 + i] * rn * gn[48 + i];
        float o0 = x1 * cr - x2 * sr, o1 = x2 * cr + x1 * sr, o2 = x3 * cc - x4 * sc, o3 = x4 * cc + x3 * sc;
        if (hh < 8) { o0 *= C2; o1 *= C2; o2 *= C2; o3 *= C2; bf16_t* o = Q + (size_t)t * DATT + hh * 64; o[i] = f2bf(o0); o[16 + i] = f2bf(o1); o[32 + i] = f2bf(o2); o[48 + i] = f2bf(o3); }
        else { bf16_t* o = K + (size_t)t * DKV + (hh - 8) * 64; o[i] = f2bf(o0); o[16 + i] = f2bf(o1); o[32 + i] = f2bf(o2); o[48 + i] = f2bf(o3); }
    }
    for (int it = tid; it < 4 * DKV; it += 256) { const int r = it / DKV, c = it % DKV; V[(size_t)(t0 + r) * DKV + c] = f2bf(zs[r][DATT + DKV + c]); }
    for (int it = tid; it < 4 * DLRU; it += 256) { const int r = it / DLRU, c = it % DLRU;
        XR[(size_t)(t0 + r) * DLRU + c] = f2bf(zs[r][DATT + 2 * DKV + c]);
        XG[(size_t)(t0 + r) * DLRU + c] = f2bf(gelu_tanh(zs[r][DATT + 2 * DKV + DLRU + c])); }
}

__global__ void __launch_bounds__(128) attn(const bf16_t* __restrict__ Q, const bf16_t* __restrict__ K, const bf16_t* __restrict__ V, bf16_t* Y) {
    __shared__ float Ks[64][64]; __shared__ float Vs[64][64];
    const int tid = threadIdx.x, h = blockIdx.y, b = blockIdx.z, kvh = h / 4;
    const size_t trow = (size_t)b * SEQ + blockIdx.x * 128 + tid;
    float q[64], o[64];
#pragma unroll
    for (int d = 0; d < 64; ++d) { q[d] = bf2f(Q[trow * DATT + h * 64 + d]); o[d] = 0.f; }
    float m = -1e30f, l = 0.f;
    for (int kt = 0; kt < SEQ / 64; ++kt) {
        __syncthreads();
        for (int i = tid; i < 64 * 64; i += 128) { const int r = i >> 6, c = i & 63; const size_t kr = (size_t)b * SEQ + kt * 64 + r;
            Ks[r][c] = bf2f(K[kr * DKV + kvh * 64 + c]); Vs[r][c] = bf2f(V[kr * DKV + kvh * 64 + c]); }
        __syncthreads();
        for (int j = 0; j < 64; ++j) {
            float s = 0.f;
#pragma unroll
            for (int d = 0; d < 64; ++d) s += q[d] * Ks[j][d];
            if (s > m) { const float f = exp2f(m - s); l *= f;
#pragma unroll
                for (int d = 0; d < 64; ++d) o[d] *= f; m = s; }
            const float p = exp2f(s - m); l += p;
#pragma unroll
            for (int d = 0; d < 64; ++d) o[d] += p * Vs[j][d];
        }
    }
    const float il = 1.f / l;
#pragma unroll
    for (int d = 0; d < 64; ++d) Y[trow * DM + h * 64 + d] = f2bf(o[d] * il);
}

__global__ void __launch_bounds__(128) lru(const bf16_t* __restrict__ XR, const float* __restrict__ cw, const float* __restrict__ cb, const float* __restrict__ wa, const float* __restrict__ ba,
                                           const float* __restrict__ wx, const float* __restrict__ bx, const float* __restrict__ lam, float* HF, float* HB) {
    __shared__ float xcs[2][64];
    const int tid = threadIdx.x, j = tid & 63, e = tid >> 6, b = blockIdx.x / NBLK, n = blockIdx.x % NBLK, c = n * 64 + j;
    float wav[64], wxv[64];
#pragma unroll
    for (int k = 0; k < 64; ++k) { wav[k] = wa[(((size_t)e * NBLK + n) * 64 + k) * 64 + j]; wxv[k] = wx[(((size_t)e * NBLK + n) * 64 + k) * 64 + j]; }
    const float bav = ba[e * DLRU + c], bxv = bx[e * DLRU + c];
    const float lm = lam[e * DLRU + c]; const float lsg = -log1pf(expf(-lm));
    const float w0 = cw[0 * DLRU + c], w1 = cw[1 * DLRU + c], w2 = cw[2 * DLRU + c], w3 = cw[3 * DLRU + c], cbv = cb[c];
    float* H = e == 0 ? HF : HB; float h = 0.f;
    for (int s = 0; s < SEQ; ++s) {
        const int t = e == 0 ? s : SEQ - 1 - s; const size_t base = (size_t)b * SEQ;
        float xc = cbv;
        if (t - 2 >= 0) xc += w0 * bf2f(XR[(base + t - 2) * DLRU + c]);
        if (t - 1 >= 0) xc += w1 * bf2f(XR[(base + t - 1) * DLRU + c]);
        xc += w2 * bf2f(XR[(base + t) * DLRU + c]);
        if (t + 1 < SEQ) xc += w3 * bf2f(XR[(base + t + 1) * DLRU + c]);
        __syncthreads();
        xcs[e][j] = xc;
        __syncthreads();
        float ga = bav, gx = bxv;
#pragma unroll
        for (int k = 0; k < 64; ++k) { const float v = xcs[e][k]; ga += v * wav[k]; gx += v * wxv[k]; }
        const float r = sigmoidf(ga), ig = sigmoidf(gx), la = 8.f * r * lsg, a = expf(la), u = sqrtf(-expm1f(2.f * la)) * (ig * xc);
        h = a * h + u;
        H[(base + t) * DLRU + c] = h;
    }
}

__global__ void __launch_bounds__(256) merge(bf16_t* Y, const float* __restrict__ HF, const float* __restrict__ HB, const bf16_t* __restrict__ XG, const float* __restrict__ ga, const float* __restrict__ gl) {
    __shared__ float red[4];
    const int tid = threadIdx.x; const size_t t = blockIdx.x;
    float a0 = bf2f(Y[t * DM + tid]), a1 = bf2f(Y[t * DM + 256 + tid]);
    float s = block_sum(a0 * a0 + a1 * a1, red); float rn = rsqrtf(s / DATT + EPS);
    Y[t * DM + tid] = f2bf(a0 * rn * ga[tid]); Y[t * DM + 256 + tid] = f2bf(a1 * rn * ga[256 + tid]);
    float l0 = (HF[t * DLRU + tid] + HB[t * DLRU + tid]) * bf2f(XG[t * DLRU + tid]);
    float l1 = (HF[t * DLRU + 256 + tid] + HB[t * DLRU + 256 + tid]) * bf2f(XG[t * DLRU + 256 + tid]);
    s = block_sum(l0 * l0 + l1 * l1, red); rn = rsqrtf(s / DLRU + EPS);
    Y[t * DM + DATT + tid] = f2bf(l0 * rn * gl[tid]); Y[t * DM + DATT + 256 + tid] = f2bf(l1 * rn * gl[256 + tid]);
}

__global__ void __launch_bounds__(256) s4(const float* __restrict__ x, const bf16_t* __restrict__ Y, const float* __restrict__ w_out, float* H) {
    __shared__ float As[DM * 4];
    const int tid = threadIdx.x, t0 = blockIdx.x * 4;
    for (int i = tid; i < DM * 4; i += 256) { const int k = i >> 2, r = i & 3; As[i] = bf2f(Y[(size_t)(t0 + r) * DM + k]); }
    __syncthreads();
    for (int j = 0; j < DM / 256; ++j) { const int col = tid + 256 * j; float acc[4] = {0.f, 0.f, 0.f, 0.f}; dot4(As, DM, w_out, DM, col, acc);
        for (int r = 0; r < 4; ++r) H[(size_t)(t0 + r) * DM + col] = x[(size_t)(t0 + r) * DM + col] + acc[r]; }
}
__global__ void __launch_bounds__(256) s5(const float* __restrict__ H, const float* __restrict__ g, const float* __restrict__ w_up, bf16_t* M) {
    __shared__ float As[DM * 4]; __shared__ float red[4]; __shared__ float rs[4];
    const int tid = threadIdx.x, t0 = blockIdx.x * 4;
    for (int r = 0; r < 4; ++r) { float s = 0.f; for (int i = tid; i < DM; i += 256) { const float v = H[(size_t)(t0 + r) * DM + i]; s += v * v; }
        s = block_sum(s, red); if (tid == 0) rs[r] = rsqrtf(s / DM + EPS); }
    __syncthreads();
    for (int i = tid; i < DM * 4; i += 256) { const int k = i >> 2, r = i & 3; As[i] = H[(size_t)(t0 + r) * DM + k] * rs[r] * g[k]; }
    __syncthreads();
    for (int j = 0; j < DFF / 256; ++j) { const int col = tid + 256 * j; float acc[4] = {0.f, 0.f, 0.f, 0.f}; dot4(As, DM, w_up, DFF, col, acc);
        for (int r = 0; r < 4; ++r) { const float v = fmaxf(acc[r], 0.f); M[(size_t)(t0 + r) * DFF + col] = f2bf(v * v); } }
}
__global__ void __launch_bounds__(256) s6(float* H, const bf16_t* __restrict__ M, const float* __restrict__ w_down) {
    __shared__ float As[2048 * 4];
    const int tid = threadIdx.x, t0 = blockIdx.x * 4;
    float acc[4][4];
#pragma unroll
    for (int j = 0; j < 4; ++j) for (int r = 0; r < 4; ++r) acc[j][r] = 0.f;
    for (int kh = 0; kh < 2; ++kh) {
        __syncthreads();
        for (int i = tid; i < 2048 * 4; i += 256) { const int k = i >> 2, r = i & 3; As[i] = bf2f(M[(size_t)(t0 + r) * DFF + kh * 2048 + k]); }
        __syncthreads();
#pragma unroll
        for (int j = 0; j < 4; ++j) dot4(As, 2048, w_down + (size_t)kh * 2048 * DM, DM, tid + 256 * j, acc[j]);
    }
#pragma unroll
    for (int j = 0; j < 4; ++j) for (int r = 0; r < 4; ++r) H[(size_t)(t0 + r) * DM + tid + 256 * j] += acc[j][r];
}
__global__ void __launch_bounds__(256) s7(float* H, const float* __restrict__ p, const float* __restrict__ g, const float* __restrict__ w_gate, const float* __restrict__ w_proj, const float* __restrict__ gf) {
    __shared__ float As[DM * 4]; __shared__ float Ps[DPLE * 4]; __shared__ float red[4]; __shared__ float rs[4];
    const int tid = threadIdx.x, t0 = blockIdx.x * 4;
    for (int r = 0; r < 4; ++r) { float s = 0.f; for (int i = tid; i < DM; i += 256) { const float v = H[(size_t)(t0 + r) * DM + i]; s += v * v; }
        s = block_sum(s, red); if (tid == 0) rs[r] = rsqrtf(s / DM + EPS); }
    __syncthreads();
    for (int i = tid; i < DM * 4; i += 256) { const int k = i >> 2, r = i & 3; As[i] = H[(size_t)(t0 + r) * DM + k] * rs[r] * g[k]; }
    for (int i = tid; i < DPLE * 4; i += 256) { const int k = i >> 2, r = i & 3; Ps[i] = p[(size_t)(t0 + r) * DPLE + k]; }
    __syncthreads();
    float h3[4][4];
#pragma unroll
    for (int j = 0; j < 4; ++j) { const int col = tid + 256 * j; float ag[4] = {0.f, 0.f, 0.f, 0.f}, ap[4] = {0.f, 0.f, 0.f, 0.f};
        dot4(As, DM, w_gate, DM, col, ag); dot4(Ps, DPLE, w_proj, DM, col, ap);
        for (int r = 0; r < 4; ++r) h3[j][r] = H[(size_t)(t0 + r) * DM + col] + sigmoidf(ag[r]) * ap[r]; }
#pragma unroll
    for (int r = 0; r < 4; ++r) { float s = 0.f; for (int j = 0; j < 4; ++j) s += h3[j][r] * h3[j][r];
        s = block_sum(s, red); const float rn = rsqrtf(s / DM + EPS);
        for (int j = 0; j < 4; ++j) { const int col = tid + 256 * j; H[(size_t)(t0 + r) * DM + col] = h3[j][r] * rn * gf[col]; } }
}
}

namespace pg8 {
#define PG8_LAS __attribute__((address_space(3)))
typedef unsigned short bf16_t;
typedef short bf16x8 __attribute__((ext_vector_type(8)));
typedef float f32x4 __attribute__((ext_vector_type(4)));
typedef unsigned u32x4 __attribute__((ext_vector_type(4)));
constexpr int BM = 256, BK = 64, HALF = 128, HTB = HALF * BK * 2  , STAGE_BYTES = 8 * HTB, NXCD = 8, WGM = 8;

__host__ __device__ __forceinline__ int lds_byte(int r, int c) { const int st = (r >> 4) * 2 + (c >> 5), rr = r & 15, cc = c & 31, ob = rr * 64 + cc * 2; return st * 1024 + (ob ^ (((ob >> 9) & 1) << 5)); }
__host__ __device__ __forceinline__ void stage_rc(int b, int& R, int& C) { const int st = b / 1024, sb = b % 1024, swz = sb ^ (((sb >> 9) & 1) << 5); R = (st >> 1) * 16 + swz / 64; C = (st & 1) * 32 + (swz % 64) / 2; }
__host__ __device__ __forceinline__ int perm32(int rho) { const int n = rho >> 4, i = rho & 15; return 8 * (i >> 2) + 4 * n + (i & 3); }

struct Unit { int pm, pn; };
struct Gemm { const bf16_t* A; const bf16_t* Bt; int M, N, K; };

struct StaticOrder {
    int nM, nN, nwg, G, c;
    __host__ __device__ void init(int M, int N, int G_, int c_) { nM = M / BM; nN = N / BM; nwg = nM * nN; G = G_; c = c_; }
    __host__ __device__ bool next(int i, Unit& u) const {
        const long L = (long)i * G + c; if (L >= nwg) return false;
        int wgid = (int)L; { const int q = nwg / NXCD, r = nwg % NXCD, xcd = wgid % NXCD, off = wgid / NXCD; wgid = (xcd < r ? xcd * (q + 1) : r * (q + 1) + (xcd - r) * q) + off; }
        const int nig = WGM * nN, gid = wgid / nig, fm = gid * WGM, gsz = (nM - fm) < WGM ? (nM - fm) : WGM;
        u.pm = fm + ((wgid % nig) % gsz); u.pn = (wgid % nig) / gsz; return true;
    }
    __device__ __forceinline__ void a_ready(const Unit&) const {}
    __device__ __forceinline__ void done(const Unit&) const {}
};

__device__ __forceinline__ unsigned cvt_pk_bf16(float lo, float hi) { unsigned r; asm volatile("v_cvt_pk_bf16_f32 %0, %1, %2" : "=v"(r) : "v"(lo), "v"(hi)); return r; }
typedef float f32x2 __attribute__((ext_vector_type(2)));
__device__ __forceinline__ f32x2 gelu_pk(f32x2 v) {
    const f32x2 av = __builtin_elementwise_abs(v), d = av * 0.2316418882f + 1.0f;
    f32x2 t; t.x = __builtin_amdgcn_rcpf(d.x); t.y = __builtin_amdgcn_rcpf(d.y);
    f32x2 q = t * 0.5307027145f + (-0.7265760135f); q = q * t + 0.7107068705f; q = q * t + (-0.142248368f); q = q * t + 0.127414796f; q = q * t;
    const f32x2 s = (v * v) * (-0.72134752044f);
    f32x2 e; e.x = __builtin_amdgcn_exp2f(s.x); e.y = __builtin_amdgcn_exp2f(s.y);
    const f32x2 m = v * (q * e), r = v - m;
    f32x2 o; o.x = v.x < 0.f ? m.x : r.x; o.y = v.y < 0.f ? m.y : r.y; return o;
}

template <int ACT  > struct EpiBf16 {
    static constexpr bool PERM = true, AFTER_DRAIN = false; static_assert(ACT == 0 || ACT == 1, "EpiBf16: ACT is 0 (none) or 1 (gelu_pk)");
    bf16_t* O; int ldc; const float* bias; int split_cols; size_t split_stride; float scale0;
    __device__ __forceinline__ void operator()(const f32x4 (&acc)[2][2][4][2], const Unit& u, int wr, int wc, int fr, int fq) const {
        const int row0 = u.pm * BM + wr * 64 + fr; int colt = u.pn * BM; bf16_t* base = O;
        float sc = 1.f; if (split_cols) { const int t = colt / split_cols; base += (size_t)t * split_stride; colt -= t * split_cols; if (t == 0) sc = scale0; }
        const int col0 = colt + wc * 32 + 8 * fq, bcol0 = u.pn * BM + wc * 32 + 8 * fq;
        f32x4 bv[2][2];
#pragma unroll
        for (int bj = 0; bj < 2; ++bj)
#pragma unroll
            for (int n = 0; n < 2; ++n) bv[bj][n] = bias ? *(const f32x4*)(bias + bcol0 + bj * HALF + 4 * n) : (f32x4){0.f, 0.f, 0.f, 0.f};
#pragma unroll
        for (int ai = 0; ai < 2; ++ai)
#pragma unroll
            for (int m = 0; m < 4; ++m) { bf16_t* rowp = base + (size_t)(row0 + ai * HALF + m * 16) * ldc + col0;
#pragma unroll
                for (int bj = 0; bj < 2; ++bj) { f32x4 v0 = acc[ai][bj][m][0] + bv[bj][0], v1 = acc[ai][bj][m][1] + bv[bj][1];
                    if (ACT == 1) { f32x2 a = gelu_pk((f32x2){v0[0], v0[1]}), b = gelu_pk((f32x2){v0[2], v0[3]}), c = gelu_pk((f32x2){v1[0], v1[1]}), d = gelu_pk((f32x2){v1[2], v1[3]});
                        v0 = (f32x4){a.x, a.y, b.x, b.y}; v1 = (f32x4){c.x, c.y, d.x, d.y}; }
                    v0 = v0 * sc; v1 = v1 * sc; u32x4 w; w.x = cvt_pk_bf16(v0[0], v0[1]); w.y = cvt_pk_bf16(v0[2], v0[3]); w.z = cvt_pk_bf16(v1[0], v1[1]); w.w = cvt_pk_bf16(v1[2], v1[3]);
                    *(u32x4*)(rowp + bj * HALF) = w; } }
    }
};
typedef unsigned u32x2 __attribute__((ext_vector_type(2)));
__device__ __forceinline__ float wsum4(float s) { s += __shfl_xor(s, 16); s += __shfl_xor(s, 32); return s; }
__device__ __forceinline__ float dot4f(const f32x4 a) { return (a[0] * a[0] + a[1] * a[1]) + (a[2] * a[2] + a[3] * a[3]); }
__device__ __forceinline__ u32x2 pack4(const f32x4 v) { u32x2 w; w.x = cvt_pk_bf16(v[0], v[1]); w.y = cvt_pk_bf16(v[2], v[3]); return w; }
__device__ __forceinline__ f32x4 unpack4(const u32x2 w) { f32x4 v; v[0] = __uint_as_float(w.x << 16); v[1] = __uint_as_float(w.x & 0xffff0000u); v[2] = __uint_as_float(w.y << 16); v[3] = __uint_as_float(w.y & 0xffff0000u); return v; }
__device__ __forceinline__ float gelu_tanh_fast(float x) {
    const float e = __builtin_amdgcn_exp2f(-2.302208198f * (x + 0.044715f * x * x * x)); return x * __builtin_amdgcn_rcpf(1.0f + e);
}
__device__ __forceinline__ float sigmoid_fast(float x) { return __builtin_amdgcn_rcpf(1.0f + __builtin_amdgcn_exp2f(-1.4426950408889634f * x)); }
__device__ __forceinline__ float rstd16(const float* ss) {
    const f32x4 a = *(const f32x4*)(ss), b = *(const f32x4*)(ss + 4), c = *(const f32x4*)(ss + 8), d = *(const f32x4*)(ss + 12);
    const float s = ((a[0] + a[1]) + (a[2] + a[3])) + ((b[0] + b[1]) + (b[2] + b[3])) + ((c[0] + c[1]) + (c[2] + c[3])) + ((d[0] + d[1]) + (d[2] + d[3]));
    return rsqrtf(s * (1.0f / 1024.0f) + EPS);
}

struct EpiIn {
    static constexpr bool PERM = false, AFTER_DRAIN = false;
    const float* rsx; const float* qn; const float* kn; const float* rope;
    bf16_t *Q, *K, *V, *XR, *XG;
    __device__ __forceinline__ void operator()(const f32x4 (&acc)[2][2][4][2], const Unit& u, int wr, int wc, int fr, int fq) const {
        const int rowb = u.pm * BM + wr * 64 + fr;
        if (u.pn < 2 || (u.pn == 2 && wc < 2)) {
            const bool isq = u.pn < 2;
            const float* gn = isq ? qn : kn; const float osc = isq ? C2 : 1.0f;
            f32x4 g[2][2];
#pragma unroll
            for (int bj = 0; bj < 2; ++bj)
#pragma unroll
                for (int n = 0; n < 2; ++n) g[bj][n] = *(const f32x4*)(gn + 32 * bj + 16 * n + 4 * fq) * osc;
#pragma unroll
            for (int ai = 0; ai < 2; ++ai) {
                const int ridx = (4 * u.pm + 2 * ai + wr) & 63;
                const f32x4 cr = *(const f32x4*)(rope + ridx * 16 + 4 * fq), sr = *(const f32x4*)(rope + 1024 + ridx * 16 + 4 * fq);
#pragma unroll
                for (int m = 0; m < 4; ++m) {
                    const int t = rowb + ai * HALF + m * 16; const float rs = rsx[t]; const int cidx = 16 * m + fr;
                    const f32x4 cc = *(const f32x4*)(rope + cidx * 16 + 4 * fq), sc = *(const f32x4*)(rope + 1024 + cidx * 16 + 4 * fq);
                    f32x4 v00 = acc[ai][0][m][0] * rs, v01 = acc[ai][0][m][1] * rs, v10 = acc[ai][1][m][0] * rs, v11 = acc[ai][1][m][1] * rs;
                    const float ss = wsum4((dot4f(v00) + dot4f(v01)) + (dot4f(v10) + dot4f(v11)));
                    const float rn = rsqrtf(ss * (1.0f / 64.0f) + EPS);
                    v00 = v00 * rn * g[0][0]; v01 = v01 * rn * g[0][1]; v10 = v10 * rn * g[1][0]; v11 = v11 * rn * g[1][1];
                    const f32x4 o0 = v00 * cr - v01 * sr, o1 = v01 * cr + v00 * sr, o2 = v10 * cc - v11 * sc, o3 = v11 * cc + v10 * sc;
                    bf16_t* dst = isq ? Q + (size_t)t * 512 + (u.pn * 4 + wc) * 64 + 4 * fq : K + (size_t)t * 128 + wc * 64 + 4 * fq;
                    *(u32x2*)(dst) = pack4(o0); *(u32x2*)(dst + 16) = pack4(o1); *(u32x2*)(dst + 32) = pack4(o2); *(u32x2*)(dst + 48) = pack4(o3);
                    asm volatile("" ::: "memory");
                }
            }
        } else if (u.pn == 2) {
#pragma unroll
            for (int ai = 0; ai < 2; ++ai)
#pragma unroll
                for (int m = 0; m < 4; ++m) {
                    const int t = rowb + ai * HALF + m * 16; const float rs = rsx[t];
                    bf16_t* dst = V + (size_t)t * 128 + (wc - 2) * 64 + 4 * fq;
#pragma unroll
                    for (int bj = 0; bj < 2; ++bj)
#pragma unroll
                        for (int n = 0; n < 2; ++n) *(u32x2*)(dst + 32 * bj + 16 * n) = pack4(acc[ai][bj][m][n] * rs);
                }
        } else {
            const bool isg = u.pn >= 5;
            bf16_t* base = (isg ? XG + (u.pn - 5) * 256 : XR + (u.pn - 3) * 256) + wc * 32 + 8 * fq;
#pragma unroll
            for (int ai = 0; ai < 2; ++ai)
#pragma unroll
                for (int m = 0; m < 4; ++m) {
                    const int t = rowb + ai * HALF + m * 16; const float rs = rsx[t];
#pragma unroll
                    for (int bj = 0; bj < 2; ++bj) {
                        f32x4 v0 = acc[ai][bj][m][0] * rs, v1 = acc[ai][bj][m][1] * rs;
                        if (isg) {
#pragma unroll
                            for (int e = 0; e < 4; ++e) { v0[e] = gelu_tanh_fast(v0[e]); v1[e] = gelu_tanh_fast(v1[e]); }
                        }
                        u32x4 w; w.x = cvt_pk_bf16(v0[0], v0[1]); w.y = cvt_pk_bf16(v0[2], v0[3]); w.z = cvt_pk_bf16(v1[0], v1[1]); w.w = cvt_pk_bf16(v1[2], v1[3]);
                        *(u32x4*)(base + (size_t)t * 512 + bj * HALF) = w;
                    }
                }
        }
    }
};

template <bool STORE_OUT> struct EpiRes {
    static constexpr bool PERM = false, AFTER_DRAIN = false;
    bf16_t* hb; float* ss;
    __device__ __forceinline__ void operator()(const f32x4 (&acc)[2][2][4][2], const Unit& u, int wr, int wc, int fr, int fq) const {
        const int rowb = u.pm * BM + wr * 64 + fr, col0 = u.pn * BM + wc * 32 + 4 * fq;
#pragma unroll
        for (int ai = 0; ai < 2; ++ai)
#pragma unroll
            for (int m = 0; m < 4; ++m) {
                const int t = rowb + ai * HALF + m * 16; const size_t off = (size_t)t * 1024 + col0; float s = 0.f;
                u32x2 bv[2][2];
#pragma unroll
                for (int bj = 0; bj < 2; ++bj)
#pragma unroll
                    for (int n = 0; n < 2; ++n) bv[bj][n] = *(const u32x2*)(hb + off + bj * HALF + n * 16);
#pragma unroll
                for (int bj = 0; bj < 2; ++bj)
#pragma unroll
                    for (int n = 0; n < 2; ++n) {
                        const f32x4 o = unpack4(bv[bj][n]) + acc[ai][bj][m][n];
                        if (STORE_OUT) *(u32x2*)(hb + off + bj * HALF + n * 16) = pack4(o); s += dot4f(o);
                    }
                s = wsum4(s); if (fq == 0) ss[(size_t)t * 16 + u.pn * 4 + wc] = s;
            }
    }
};

struct EpiUp {
    static constexpr bool PERM = true, AFTER_DRAIN = false;
    const float* ss; bf16_t* M;
    __device__ __forceinline__ void operator()(const f32x4 (&acc)[2][2][4][2], const Unit& u, int wr, int wc, int fr, int fq) const {
        const int rowb = u.pm * BM + wr * 64 + fr, col0 = u.pn * BM + wc * 32 + 8 * fq;
#pragma unroll
        for (int ai = 0; ai < 2; ++ai)
#pragma unroll
            for (int m = 0; m < 4; ++m) {
                const int t = rowb + ai * HALF + m * 16; const float rs = rstd16(ss + (size_t)t * 16);
#pragma unroll
                for (int bj = 0; bj < 2; ++bj) {
                    f32x4 v0 = acc[ai][bj][m][0] * rs, v1 = acc[ai][bj][m][1] * rs;
#pragma unroll
                    for (int e = 0; e < 4; ++e) { const float a = fmaxf(v0[e], 0.f), b = fmaxf(v1[e], 0.f); v0[e] = a * a; v1[e] = b * b; }
                    u32x4 w; w.x = cvt_pk_bf16(v0[0], v0[1]); w.y = cvt_pk_bf16(v0[2], v0[3]); w.z = cvt_pk_bf16(v1[0], v1[1]); w.w = cvt_pk_bf16(v1[2], v1[3]);
                    *(u32x4*)(M + (size_t)t * 4096 + col0 + bj * HALF) = w;
                }
            }
    }
};

template <bool STORE_OUT> struct EpiGate {
    static constexpr bool PERM = false, AFTER_DRAIN = false;
    const float* ss2; const bf16_t* pp; const bf16_t* hb; bf16_t* h3b; float* ss3;
    __device__ __forceinline__ void operator()(const f32x4 (&acc)[2][2][4][2], const Unit& u, int wr, int wc, int fr, int fq) const {
        const int rowb = u.pm * BM + wr * 64 + fr, col0 = u.pn * BM + wc * 32 + 4 * fq;
#pragma unroll
        for (int ai = 0; ai < 2; ++ai)
#pragma unroll
            for (int m = 0; m < 4; ++m) {
                const int t = rowb + ai * HALF + m * 16; const float rs = rstd16(ss2 + (size_t)t * 16); const size_t off = (size_t)t * 1024 + col0; float s = 0.f;
#pragma unroll
                for (int bj = 0; bj < 2; ++bj)
#pragma unroll
                    for (int n = 0; n < 2; ++n) {
                        const f32x4 pv = unpack4(*(const u32x2*)(pp + off + bj * HALF + n * 16)); const f32x4 a = acc[ai][bj][m][n] * rs; f32x4 o = unpack4(*(const u32x2*)(hb + off + bj * HALF + n * 16));
#pragma unroll
                        for (int e = 0; e < 4; ++e) o[e] += sigmoid_fast(a[e]) * pv[e];
                        if (STORE_OUT) *(u32x2*)(h3b + off + bj * HALF + n * 16) = pack4(o); s += dot4f(o);
                    }
                s = wsum4(s); if (fq == 0) ss3[(size_t)t * 16 + u.pn * 4 + wc] = s;
            }
    }
};

struct PpOrder {
    int c;
    __device__ __forceinline__ bool next(int i, Unit& u) const { if (c < 192 || i >= 4) return false; const int idx = (c - 192) * 4 + i; u.pm = idx >> 2; u.pn = idx & 3; return true; }
    __device__ __forceinline__ void a_ready(const Unit&) const {}
    __device__ __forceinline__ void done(const Unit&) const {}
};
template <class Epi, class Sched, bool ALIGN_EPI = false, bool SP2 = false>
__device__ __forceinline__ void gemm_phase(PG8_LAS unsigned char* lds, const Gemm g, const Sched& S, const Epi& E) {
    const int tid = threadIdx.x, wid = __builtin_amdgcn_readfirstlane(tid >> 6), lane = tid & 63, wr = wid >> 2, wc = wid & 3, fr = lane & 15, fq = lane >> 4;
    const int K = g.K, nt = K / BK;
    unsigned voffA[2], voffB[2];
#pragma unroll
    for (int i = 0; i < 2; ++i) { int R, C; stage_rc(tid * 16 + i * 8192, R, C); const int Rb = Epi::PERM ? ((R & ~31) + perm32(R & 31)) : R;
        voffA[i] = (unsigned)(R * K + C) * 2u; voffB[i] = (unsigned)(Rb * K + C) * 2u; }
    const size_t kstep = (size_t)(BK * 2);
    const size_t hstep = (size_t)HALF * K * 2;
    const size_t tstep = 2 * hstep;
    const unsigned ldsw = (unsigned)wid * 1024u;
    const int aoff = lds_byte(wr * 64 + fr, fq * 8), boff = lds_byte(wc * 32 + fr, fq * 8);
#define PG8_SA(b, h) (((b) * 2 + (h)) * HTB)
#define PG8_SB(b, h) ((4 + (b) * 2 + (h)) * HTB)
#define PG8_STAGE(bufoff, gbase, voff) do { _Pragma("unroll") for (int _i = 0; _i < 2; ++_i) \
        __builtin_amdgcn_global_load_lds((const unsigned*)((const char*)(gbase) + (voff)[_i]), (PG8_LAS unsigned*)(lds + (bufoff) + ldsw + _i * 8192), 16, 0, 0); } while (0)
#define PG8_LDA(dst, b, h) do { _Pragma("unroll") for (int m = 0; m < 4; ++m) _Pragma("unroll") for (int k = 0; k < 2; ++k) dst[m][k] = *(const PG8_LAS bf16x8*)(lds + PG8_SA(b, h) + aoff + m * 2048 + k * 1024); } while (0)
#define PG8_LDB(dst, b, h) do { _Pragma("unroll") for (int n = 0; n < 2; ++n) _Pragma("unroll") for (int k = 0; k < 2; ++k) dst[n][k] = *(const PG8_LAS bf16x8*)(lds + PG8_SB(b, h) + boff + n * 2048 + k * 1024); } while (0)
#define PG8_MMA(ai, bj, At, Bt) do { __builtin_amdgcn_s_setprio(1); _Pragma("unroll") for (int m = 0; m < 4; ++m) _Pragma("unroll") for (int n = 0; n < 2; ++n) _Pragma("unroll") for (int k = 0; k < 2; ++k) \
        acc[ai][bj][m][n] = __builtin_amdgcn_mfma_f32_16x16x32_bf16(Bt[n][k], At[m][k], acc[ai][bj][m][n], 0, 0, 0); __builtin_amdgcn_s_setprio(0); } while (0)
#define PG8_WAIT_V(n) asm volatile("s_waitcnt vmcnt(" #n ")" ::: "memory")
#define PG8_WAIT_L(n) asm volatile("s_waitcnt lgkmcnt(" #n ")" ::: "memory")
#define PG8_BAR __builtin_amdgcn_s_barrier()
#define PG8_SCHED __builtin_amdgcn_sched_barrier(0)
    Unit cur, nxt; int ui = 0;
    if (!S.next(0, cur)) return;
    f32x4 acc[2][2][4][2];
#pragma unroll
    for (int a = 0; a < 2; ++a)
#pragma unroll
        for (int b = 0; b < 2; ++b)
#pragma unroll
            for (int m = 0; m < 4; ++m)
#pragma unroll
                for (int n = 0; n < 2; ++n) acc[a][b][m][n] = (f32x4){0.f, 0.f, 0.f, 0.f};
    bf16x8 At[4][2], B0[2][2], B1[2][2];
    const char* cA = (const char*)g.A + (size_t)cur.pm * tstep; const char* cB = (const char*)g.Bt + (size_t)cur.pn * tstep;
    S.a_ready(cur);
    if constexpr (SP2) {
        PG8_STAGE(PG8_SB(0, 0), cB, voffB); PG8_STAGE(PG8_SB(0, 1), cB + hstep, voffB); PG8_STAGE(PG8_SA(0, 0), cA, voffA); PG8_STAGE(PG8_SA(0, 1), cA + hstep, voffA);
        if (wr == 1) PG8_BAR;
        PG8_WAIT_V(2); PG8_BAR;
        PG8_STAGE(PG8_SB(1, 0), cB + kstep, voffB); PG8_STAGE(PG8_SA(1, 0), cA + kstep, voffA); PG8_STAGE(PG8_SB(1, 1), cB + hstep + kstep, voffB);
        PG8_WAIT_V(6); PG8_BAR;
    } else {
        PG8_STAGE(PG8_SB(0, 0), cB, voffB); PG8_STAGE(PG8_SA(0, 0), cA, voffA); PG8_STAGE(PG8_SB(0, 1), cB + hstep, voffB); PG8_STAGE(PG8_SA(0, 1), cA + hstep, voffA);
        if (wr == 1) PG8_BAR;
        PG8_WAIT_V(4); PG8_BAR;
        PG8_STAGE(PG8_SB(1, 0), cB + kstep, voffB); PG8_STAGE(PG8_SA(1, 0), cA + kstep, voffA); PG8_STAGE(PG8_SB(1, 1), cB + hstep + kstep, voffB);
        PG8_WAIT_V(6); PG8_BAR;
    }
    for (;;) {
        const bool has_next = S.next(ui + 1, nxt);
        const char* nA = has_next ? (const char*)g.A + (size_t)nxt.pm * tstep : cA; const char* nB = has_next ? (const char*)g.Bt + (size_t)nxt.pn * tstep : cB;
        for (int t = 0; t < nt; t += 2) {
            const bool last = (t == nt - 2);
            const char* a1 = cA + (size_t)(t + 1) * kstep;
            const char* a2 = last ? nA : cA + (size_t)(t + 2) * kstep; const char* b2 = last ? nB : cB + (size_t)(t + 2) * kstep;
            const char* a3 = a2 + kstep; const char* b3 = b2 + kstep;
            if (last && has_next) S.a_ready(nxt);
            if constexpr (SP2) {
            PG8_LDB(B0, 0, 0); PG8_LDB(B1, 0, 1); PG8_SCHED; PG8_LDA(At, 0, 0); PG8_STAGE(PG8_SA(1, 1), a1 + hstep, voffA);
            PG8_WAIT_V(8); PG8_WAIT_L(0); PG8_BAR; PG8_MMA(0, 0, At, B0); PG8_MMA(0, 1, At, B1); PG8_BAR; PG8_SCHED;
            PG8_LDA(At, 0, 1); PG8_STAGE(PG8_SB(0, 0), b2, voffB); PG8_STAGE(PG8_SB(0, 1), b2 + hstep, voffB); PG8_STAGE(PG8_SA(0, 0), a2, voffA);
            PG8_WAIT_V(8); PG8_WAIT_L(0); PG8_BAR; PG8_MMA(1, 0, At, B0); PG8_MMA(1, 1, At, B1); PG8_BAR; PG8_SCHED;
            PG8_LDB(B0, 1, 0); PG8_LDB(B1, 1, 1); PG8_SCHED; PG8_LDA(At, 1, 0); PG8_STAGE(PG8_SA(0, 1), a2 + hstep, voffA);
            PG8_WAIT_V(8); PG8_WAIT_L(0); PG8_BAR; PG8_MMA(0, 0, At, B0); PG8_MMA(0, 1, At, B1); PG8_BAR; PG8_SCHED;
            PG8_LDA(At, 1, 1); PG8_STAGE(PG8_SB(1, 0), b3, voffB); PG8_STAGE(PG8_SB(1, 1), b3 + hstep, voffB); PG8_STAGE(PG8_SA(1, 0), a3, voffA);
            PG8_WAIT_V(8); PG8_WAIT_L(0); PG8_BAR; PG8_MMA(1, 0, At, B0); PG8_MMA(1, 1, At, B1); PG8_BAR; PG8_SCHED;
            } else {
            PG8_LDB(B0, 0, 0); PG8_SCHED; PG8_LDA(At, 0, 0); PG8_STAGE(PG8_SA(1, 1), a1 + hstep, voffA);
            PG8_WAIT_L(8); PG8_BAR; PG8_WAIT_L(0); PG8_MMA(0, 0, At, B0); PG8_BAR; PG8_SCHED;
            PG8_LDB(B1, 0, 1); PG8_STAGE(PG8_SB(0, 0), b2, voffB);
            PG8_BAR; PG8_WAIT_L(0); PG8_MMA(0, 1, At, B1); PG8_BAR;
            PG8_LDA(At, 0, 1); PG8_STAGE(PG8_SA(0, 0), a2, voffA);
            PG8_BAR; PG8_WAIT_L(0); PG8_MMA(1, 0, At, B0); PG8_BAR; PG8_SCHED;
            PG8_STAGE(PG8_SB(0, 1), b2 + hstep, voffB);
            PG8_WAIT_V(6); PG8_BAR; PG8_MMA(1, 1, At, B1); PG8_BAR;
            PG8_LDB(B0, 1, 0); PG8_SCHED; PG8_LDA(At, 1, 0); PG8_STAGE(PG8_SA(0, 1), a2 + hstep, voffA);
            PG8_WAIT_L(8); PG8_BAR; PG8_WAIT_L(0); PG8_MMA(0, 0, At, B0); PG8_BAR; PG8_SCHED;
            PG8_LDB(B1, 1, 1); PG8_STAGE(PG8_SB(1, 0), b3, voffB);
            PG8_BAR; PG8_WAIT_L(0); PG8_MMA(0, 1, At, B1); PG8_BAR;
            PG8_LDA(At, 1, 1); PG8_STAGE(PG8_SA(1, 0), a3, voffA);
            PG8_BAR; PG8_WAIT_L(0); PG8_MMA(1, 0, At, B0); PG8_BAR; PG8_SCHED;
            PG8_STAGE(PG8_SB(1, 1), b3 + hstep, voffB);
            PG8_WAIT_V(6); PG8_BAR; PG8_MMA(1, 1, At, B1); PG8_BAR;
            }
        }
        if constexpr (ALIGN_EPI) { if (wr == 0) PG8_BAR; }
        if constexpr (!Epi::AFTER_DRAIN) { E(acc, cur, wr, wc, fr, fq); S.done(cur); }
        if (!has_next) break;
#pragma unroll
        for (int a = 0; a < 2; ++a)
#pragma unroll
            for (int b = 0; b < 2; ++b)
#pragma unroll
                for (int m = 0; m < 4; ++m)
#pragma unroll
                    for (int n = 0; n < 2; ++n) acc[a][b][m][n] = (f32x4){0.f, 0.f, 0.f, 0.f};
        cur = nxt; cA = nA; cB = nB; ++ui;
        if constexpr (ALIGN_EPI) { if (wr == 1) PG8_BAR; }
    }
    PG8_WAIT_V(0);
    if constexpr (!ALIGN_EPI) { if (wr == 0) PG8_BAR; }
    PG8_BAR;
    if constexpr (Epi::AFTER_DRAIN) { E.fused(acc, cur, wr, wc, fr, fq, lds, wid, lane); S.done(cur); }
#undef PG8_SA
#undef PG8_SB
#undef PG8_STAGE
#undef PG8_LDA
#undef PG8_LDB
#undef PG8_MMA
#undef PG8_WAIT_V
#undef PG8_WAIT_L
#undef PG8_BAR
#undef PG8_SCHED
}
}

#ifndef PG8_SP2
#define PG8_SP2 true
#endif
#ifndef PG8_ALIGN
#define PG8_ALIGN true
#endif
#include <hip/hip_bf16.h>
#include <cmath>
namespace attn_body {
using bf16=__hip_bfloat16;
using bf16x8=__attribute__((ext_vector_type(8)))short;
using s16x4=__attribute__((ext_vector_type(4)))short;
using f32x16=__attribute__((ext_vector_type(16)))float;
using u32x4=__attribute__((ext_vector_type(4)))unsigned;
constexpr int BATCH=4,NHEAD=8,SEQ=4096,D=64,QP=512,KP=128,OP=1024;
constexpr int NW=8,QBLK=32,QB=QBLK*NW,KVBLK=64,NQB=SEQ/QB;
constexpr int ATTN_UNIT_ROWS=QB;
__device__ __forceinline__ int crow(int r,int hi){return (r&3)+8*(r>>2)+4*hi;}
#define SBAR() __builtin_amdgcn_sched_barrier(0)
__device__ __forceinline__ void cmask(f32x16&p0,f32x16&p1,int jb,int qrel,int hi){
  const float NEG=-INFINITY; int kb=64*jb+4*hi;
  #pragma unroll
  for(int r=0;r<16;++r){int kv=kb+(r&3)+8*(r>>2); if(kv>qrel)p0[r]=NEG; if(kv+32>qrel)p1[r]=NEG;}
}

constexpr int NSLOT=3, SLOTB=8192;
constexpr int LDS_K=0, LDS_V=NSLOT*SLOTB, LDS_WS=2*NSLOT*SLOTB, LDS_OST=LDS_WS+NW*64*4, LDS_BYTES=LDS_OST+NW*4096;
constexpr float C2=0.125f*1.4426950408889634f;
__device__ __forceinline__ void glds16(const void*gsrc,unsigned lds_dst){unsigned keep;
  asm volatile("s_mov_b32 %0, m0\n\ts_mov_b32 m0, %2\n\ts_nop 0\n\tglobal_load_lds_dwordx4 %1, off\n\ts_mov_b32 m0, %0":"=&s"(keep):"v"(gsrc),"s"(lds_dst):"memory");}
__device__ __forceinline__ float max3f(float a,float b,float c){float r;asm("v_max3_f32 %0, %1, %2, %3":"=v"(r):"v"(a),"v"(b),"v"(c));return r;}
__device__ __forceinline__ float max2f(float a,float b){float r;asm("v_max_f32_e32 %0, %1, %2":"=v"(r):"v"(a),"v"(b));return r;}
__device__ __forceinline__ float fadd_s(float a,float b){float r;asm("v_add_f32_e32 %0, %1, %2":"=v"(r):"v"(a),"v"(b));return r;}
__device__ __forceinline__ float fsub_s(float a,float b){float r;asm("v_sub_f32_e32 %0, %1, %2":"=v"(r):"v"(a),"v"(b));return r;}
typedef float f32x2_t __attribute__((ext_vector_type(2))); typedef __bf16 bf16x2_t __attribute__((ext_vector_type(2)));
__device__ __forceinline__ unsigned cvtpk_s(float lo,float hi){f32x2_t v={lo,hi};bf16x2_t b=__builtin_convertvector(v,bf16x2_t);return __builtin_bit_cast(unsigned,b);}
#define WAIT_BAR(N) asm volatile("s_waitcnt vmcnt(" #N ") lgkmcnt(0)\n\ts_barrier":::"memory")

__device__ __forceinline__ void qkt(f32x16&p0,f32x16&p1,const char*Kslot,const bf16x8*qr,const f32x16&negm,int r32,int hi){
  const char*kb=Kslot+hi*1024+r32*16;
  #pragma unroll
  for(int d0=0;d0<4;++d0){
    const bf16x8 b0=*reinterpret_cast<const bf16x8*>(kb+d0*2048);
    const bf16x8 b1=*reinterpret_cast<const bf16x8*>(kb+d0*2048+512);
    if(d0==0){p0=__builtin_amdgcn_mfma_f32_32x32x16_bf16(b0,qr[0],negm,0,0,0);p1=__builtin_amdgcn_mfma_f32_32x32x16_bf16(b1,qr[0],negm,0,0,0);}
    else{p0=__builtin_amdgcn_mfma_f32_32x32x16_bf16(b0,qr[d0],p0,0,0,0);p1=__builtin_amdgcn_mfma_f32_32x32x16_bf16(b1,qr[d0],p1,0,0,0);}}
}
typedef __attribute__((address_space(3))) const char* lds_cptr;
typedef short v4i16_t __attribute__((ext_vector_type(4)));
__device__ __forceinline__ void kload8(bf16x8*kf,lds_cptr kp){
  kf[0]=*(const __attribute__((address_space(3))) bf16x8*)(kp);      kf[1]=*(const __attribute__((address_space(3))) bf16x8*)(kp+512);
  kf[2]=*(const __attribute__((address_space(3))) bf16x8*)(kp+2048); kf[3]=*(const __attribute__((address_space(3))) bf16x8*)(kp+2560);
  kf[4]=*(const __attribute__((address_space(3))) bf16x8*)(kp+4096); kf[5]=*(const __attribute__((address_space(3))) bf16x8*)(kp+4608);
  kf[6]=*(const __attribute__((address_space(3))) bf16x8*)(kp+6144); kf[7]=*(const __attribute__((address_space(3))) bf16x8*)(kp+6656);
}
__device__ __forceinline__ void kload2(bf16x8*kf,lds_cptr kp,int j){ kf[2*j]=*(const __attribute__((address_space(3))) bf16x8*)(kp+j*2048); kf[2*j+1]=*(const __attribute__((address_space(3))) bf16x8*)(kp+j*2048+512); }
__device__ __forceinline__ s16x4 vtr(lds_cptr p){ return __builtin_bit_cast(s16x4,__builtin_amdgcn_ds_read_tr16_b64_v4i16((__attribute__((address_space(3))) v4i16_t*)p)); }
__device__ __forceinline__ float rowmax(const f32x16&p0,const f32x16&p1){
  float a=max3f(p0[0],p0[1],p1[0]),b=max3f(p0[2],p0[3],p1[1]);a=max3f(a,p1[2],p1[3]);
  #pragma unroll
  for(int r=4;r<16;r+=4){a=max3f(a,p0[r],p0[r+1]);b=max3f(b,p0[r+2],p0[r+3]);a=max3f(a,p1[r],p1[r+1]);b=max3f(b,p1[r+2],p1[r+3]);}
  const float m=max2f(a,b);
  auto rr=__builtin_amdgcn_permlane32_swap(__float_as_uint(m),__float_as_uint(m),false,false);
  return max2f(__uint_as_float(rr[0]),__uint_as_float(rr[1]));
}
__device__ __forceinline__ void pv(f32x16*o,int vb,bf16x8 pa0,bf16x8 pa1,bf16x8 pa2,bf16x8 pa3){
  #pragma unroll
  for(int d0=0;d0<2;++d0){s16x4 lo[4],hi[4];
    #pragma unroll
    for(int ks=0;ks<4;++ks){
      asm volatile("ds_read_b64_tr_b16 %0,%1 offset:%c2":"=&v"(lo[ks]):"v"(vb),"i"(d0*4096+ks*1024):"memory");
      asm volatile("ds_read_b64_tr_b16 %0,%1 offset:%c2":"=&v"(hi[ks]):"v"(vb),"i"(d0*4096+ks*1024+512):"memory");}
    asm volatile("s_waitcnt lgkmcnt(0)":::"memory");SBAR();
    #define PK(k) (bf16x8){lo[k][0],lo[k][1],lo[k][2],lo[k][3],hi[k][0],hi[k][1],hi[k][2],hi[k][3]}
    o[d0]=__builtin_amdgcn_mfma_f32_32x32x16_bf16(pa0,PK(0),o[d0],0,0,0);
    o[d0]=__builtin_amdgcn_mfma_f32_32x32x16_bf16(pa1,PK(1),o[d0],0,0,0);
    o[d0]=__builtin_amdgcn_mfma_f32_32x32x16_bf16(pa2,PK(2),o[d0],0,0,0);
    o[d0]=__builtin_amdgcn_mfma_f32_32x32x16_bf16(pa3,PK(3),o[d0],0,0,0);
    #undef PK
  }
}

#ifndef ATTN_STORE16
#define ATTN_STORE16(p,v) (*(u32x4*)(p)=(v))
#endif
template<int THRL> __device__ __forceinline__ void attn_unit(int b,int h,int qb,const bf16*Q,const bf16*__restrict__ K,const bf16*__restrict__ V,bf16*O,char*shm){
  const int tid=threadIdx.x,lane=tid&63,r32=lane&31,hi=lane>>5; const int wid=__builtin_amdgcn_readfirstlane(tid>>6);
  const long rowbase=(long)b*SEQ; const int q0=qb*QB;
  const bf16*Qw=Q+(rowbase+q0+wid*QBLK)*QP+h*D;
  const bf16*Kh=K+rowbase*KP+(h>>2)*D,*Vh=V+rowbase*KP+(h>>2)*D;
  const unsigned lds0=(unsigned)(uintptr_t)shm;
  float*wsf=(float*)(shm+LDS_WS)+wid*64;
  const bf16*ksrc=Kh+(long)lane*KP+wid*8;
  const bf16*vsrc=Vh+(long)(16*(wid&3)+(lane>>2))*KP+(wid>>2)*32+(lane&3)*8;
  const unsigned kdst=lds0+LDS_K+wid*1024, vdst=lds0+LDS_V+wid*1024;
  #define DMA_K(t,slot) glds16(ksrc+(long)(t)*KVBLK*KP,(unsigned)__builtin_amdgcn_readfirstlane(kdst+(slot)))
  #define DMA_V(t,slot) glds16(vsrc+(long)(t)*KVBLK*KP,(unsigned)__builtin_amdgcn_readfirstlane(vdst+(slot)))
  const int vb0=(int)(lds0+LDS_V)+((lane>>4)&1)*32+(lane&3)*8+(4*hi+((lane&15)>>2))*64;
  const char*Kbase=shm+LDS_K; bf16x8 kf[8];
  const lds_cptr shm3=(lds_cptr)shm; const lds_cptr kp0=shm3+LDS_K+hi*1024+r32*16; const lds_cptr vp0=shm3+LDS_V+((lane>>4)&1)*32+(lane&3)*8+(4*hi+((lane&15)>>2))*64;
  const int NT=SEQ/KVBLK;
  DMA_K(0,0);DMA_V(0,0);DMA_K(1,SLOTB);
  bf16x8 qr[4];
  #pragma unroll
  for(int d0=0;d0<4;++d0)qr[d0]=*reinterpret_cast<const bf16x8*>(&Qw[(long)r32*QP+d0*16+hi*8]);
  float mhat=0.f,l_reg=0.f;f32x16 o[2];o[0]=f32x16{};o[1]=f32x16{};f32x16 negm=f32x16{};asm volatile("":"+v"(negm));
  const int qrel=wid*QBLK+r32;
  #define CMASK(P0,P1,t) do{}while(0)
  bool resc=false;
  #define START(P0,P1) do{ const float rm=rowmax(P0,P1); resc=false; \
    { const float dl=rm; mhat=fadd_s(mhat,dl); \
      _Pragma("unroll") for(int r=0;r<16;++r){P0[r]=fsub_s(P0[r],dl);P1[r]=fsub_s(P1[r],dl);} \
      _Pragma("unroll") for(int r=0;r<16;++r)negm[r]=-mhat; asm volatile("":"+v"(negm)); } \
    _Pragma("unroll") for(int r=0;r<16;++r)P0[r]=__builtin_amdgcn_exp2f(P0[r]); }while(0)
  #define RESC() do{ if(resc){ asm volatile("s_waitcnt lgkmcnt(0)":::"memory"); \
      _Pragma("unroll") for(int d_=0;d_<2;++d_) _Pragma("unroll") for(int r=0;r<16;++r)o[d_][r]*=wsf[crow(r,hi)]; } }while(0)
  f32x16 pA0,pA1,pB0,pB1;
  int sl_prev=0,sl_cur=0,sl_next=SLOTB;
  #define ROT() do{sl_prev=sl_cur;sl_cur=sl_next;sl_next=(sl_next==(NSLOT-1)*SLOTB)?0:sl_next+SLOTB;}while(0)
  DMA_K(2,2*SLOTB);
  WAIT_BAR(3);
  qkt(pA0,pA1,Kbase,qr,negm,r32,hi);asm volatile("s_nop 15\n\ts_nop 7":"+v"(pA0),"+v"(pA1));CMASK(pA0,pA1,0);
  START(pA0,pA1);
  _Pragma("unroll") for(int r=0;r<16;++r)pA1[r]=__builtin_amdgcn_exp2f(pA1[r]);
  WAIT_BAR(0);
  DMA_K(3,0);DMA_V(1,SLOTB);
  ROT();
  kload8(kf,kp0+sl_cur);
  WAIT_BAR(2);
  s16x4 vlo[8],vhi[8]; u32x4 pw0,pw1,pw2,pw3;
  #define PKW(P,B) cvtpk_s(P[B],P[B+1])
  #define PAF(k) __builtin_bit_cast(bf16x8,pw##k)
  #define VFR(i) (bf16x8){vlo[i][0],vlo[i][1],vlo[i][2],vlo[i][3],vhi[i][0],vhi[i][1],vhi[i][2],vhi[i][3]}
  #define PIN(x) asm volatile("":"+v"(x))
  #define MX3(a,b,c) __builtin_fmaxf(__builtin_fmaxf((a),(b)),(c))
  #define GAPA(MF,A0,A1,A2,A3,W0,W1,PW) do{ MF; sacc+=A0; sacc+=A1; sacc+=A2; sacc+=A3; PIN(sacc); W0; W1; PIN(PW); SBAR(); }while(0)
  #define EX(v) __builtin_amdgcn_exp2f(v)
  #define GAPB(MF,X,B) do{ MF; X[B]=EX(X[B]); X[B+1]=EX(X[B+1]); X[B+2]=EX(X[B+2]); X[B+3]=EX(X[B+3]); PIN(X); SBAR(); }while(0)
  #define VRD(i) do{ vlo[i]=vtr(vp_+(((i)>>2)*4096+((i)&3)*1024)); vhi[i]=vtr(vp_+(((i)>>2)*4096+((i)&3)*1024+512)); }while(0)
  #define KRD(G,j) do{ if(G){ kload2(kf,kp0+sl_next,j); SBAR(); } }while(0)
  #define STEP(C0,C1,P0,P1,t,GK,GV,GL) do{ SBAR(); \
    const lds_cptr vp_=vp0+sl_prev; \
    VRD(0); SBAR(); float sacc=(P0[0]+P0[1]); \
    GAPA(C0=__builtin_amdgcn_mfma_f32_32x32x16_bf16(kf[0],qr[0],negm,0,0,0), P0[2],P0[3],P0[4],P0[5],     pw0[0]=PKW(P0,0), pw0[1]=PKW(P0,2), pw0); \
    VRD(4); SBAR(); GAPA(C1=__builtin_amdgcn_mfma_f32_32x32x16_bf16(kf[1],qr[0],negm,0,0,0), P0[6],P0[7],P0[8],P0[9],     pw0[2]=PKW(P0,4), pw0[3]=PKW(P0,6), pw0); \
    VRD(1); SBAR(); GAPA(C0=__builtin_amdgcn_mfma_f32_32x32x16_bf16(kf[2],qr[1],C0,0,0,0),   P0[10],P0[11],P0[12],P0[13], pw1[0]=PKW(P0,8), pw1[1]=PKW(P0,10), pw1); \
    VRD(5); SBAR(); GAPA(C1=__builtin_amdgcn_mfma_f32_32x32x16_bf16(kf[3],qr[1],C1,0,0,0),   P0[14],P0[15],P1[0],P1[1],   pw1[2]=PKW(P0,12),pw1[3]=PKW(P0,14), pw1); \
    VRD(2); SBAR(); GAPA(C0=__builtin_amdgcn_mfma_f32_32x32x16_bf16(kf[4],qr[2],C0,0,0,0),   P1[2],P1[3],P1[4],P1[5],     pw2[0]=PKW(P1,0), pw2[1]=PKW(P1,2), pw2); \
    VRD(6); SBAR(); GAPA(C1=__builtin_amdgcn_mfma_f32_32x32x16_bf16(kf[5],qr[2],C1,0,0,0),   P1[6],P1[7],P1[8],P1[9],     pw2[2]=PKW(P1,4), pw2[3]=PKW(P1,6), pw2); \
    VRD(3); SBAR(); GAPA(C0=__builtin_amdgcn_mfma_f32_32x32x16_bf16(kf[6],qr[3],C0,0,0,0),   P1[10],P1[11],P1[12],P1[13], pw3[0]=PKW(P1,8), pw3[1]=PKW(P1,10), pw3); \
    VRD(7); SBAR(); GAPA(C1=__builtin_amdgcn_mfma_f32_32x32x16_bf16(kf[7],qr[3],C1,0,0,0),   P1[14],P1[15],0.f,0.f,       pw3[2]=PKW(P1,12),pw3[3]=PKW(P1,14), pw3); \
    l_reg+=sacc; \
    if(GK){DMA_K((t)+3,sl_cur);} if(GV){DMA_V((t)+1,sl_next);} \
    CMASK(C0,C1,t); \
    { float a=MX3(C0[0],C0[1],C1[0]),b=MX3(C0[2],C0[3],C1[1]); a=MX3(a,C1[2],C1[3]); \
      _Pragma("unroll") for(int r=4;r<16;r+=4){a=MX3(a,C0[r],C0[r+1]);b=MX3(b,C0[r+2],C0[r+3]);a=MX3(a,C1[r],C1[r+1]);b=MX3(b,C1[r+2],C1[r+3]);} \
      float rm=__builtin_fmaxf(a,b); { auto rr=__builtin_amdgcn_permlane32_swap(__float_as_uint(rm),__float_as_uint(rm),false,false); rm=__builtin_fmaxf(__uint_as_float(rr[0]),__uint_as_float(rr[1])); } \
      resc=false; \
      if(__builtin_expect(__any(rm>(float)THRL),0)){ const float dl=__builtin_fmaxf(rm,0.f); mhat+=dl; \
        _Pragma("unroll") for(int r=0;r<16;++r){C0[r]-=dl;C1[r]-=dl;} \
        _Pragma("unroll") for(int r=0;r<16;++r)negm[r]=-mhat; asm volatile("":"+v"(negm)); \
        const float f=__builtin_amdgcn_exp2f(-dl); l_reg*=f; if(hi==0)wsf[r32]=f; resc=true; } } \
    SBAR(); \
    GAPB(o[0]=__builtin_amdgcn_mfma_f32_32x32x16_bf16(PAF(0),VFR(0),o[0],0,0,0), C0,0); \
    GAPB(o[1]=__builtin_amdgcn_mfma_f32_32x32x16_bf16(PAF(0),VFR(4),o[1],0,0,0), C0,4); \
    KRD(GL,0); GAPB(o[0]=__builtin_amdgcn_mfma_f32_32x32x16_bf16(PAF(1),VFR(1),o[0],0,0,0), C0,8); \
    KRD(GL,1); GAPB(o[1]=__builtin_amdgcn_mfma_f32_32x32x16_bf16(PAF(1),VFR(5),o[1],0,0,0), C0,12); \
    KRD(GL,2); GAPB(o[0]=__builtin_amdgcn_mfma_f32_32x32x16_bf16(PAF(2),VFR(2),o[0],0,0,0), C1,0); \
    KRD(GL,3); GAPB(o[1]=__builtin_amdgcn_mfma_f32_32x32x16_bf16(PAF(2),VFR(6),o[1],0,0,0), C1,4); \
    GAPB(o[0]=__builtin_amdgcn_mfma_f32_32x32x16_bf16(PAF(3),VFR(3),o[0],0,0,0), C1,8); \
    GAPB(o[1]=__builtin_amdgcn_mfma_f32_32x32x16_bf16(PAF(3),VFR(7),o[1],0,0,0), C1,12); \
    }while(0)
  int t=1;
  #undef CMASK
  #define CMASK(P0,P1,t) do{}while(0)
  for(;t+5<NT;t+=2){
    STEP(pB0,pB1,pA0,pA1,t,true,true,true);     WAIT_BAR(2); RESC(); ROT();
    STEP(pA0,pA1,pB0,pB1,t+1,true,true,true);   WAIT_BAR(2); RESC(); ROT();
  }
  #undef CMASK
  #define CMASK(P0,P1,t) do{}while(0)
  #define ENDW(tt) do{ if((tt)+3<NT){WAIT_BAR(2);} else if((tt)+2<NT){WAIT_BAR(1);} else {WAIT_BAR(0);} }while(0)
  for(;t+1<NT;t+=2){
    STEP(pB0,pB1,pA0,pA1,t,(t+3<NT),(t+1<NT),(t+1<NT));       ENDW(t);   RESC(); ROT();
    STEP(pA0,pA1,pB0,pB1,t+1,(t+4<NT),(t+2<NT),(t+2<NT));     ENDW(t+1); RESC(); ROT();
  }
  STEP(pB0,pB1,pA0,pA1,NT-1,false,false,false); RESC();
  { float sacc=pB0[0]+pB0[1]; _Pragma("unroll") for(int r=2;r<16;++r)sacc+=pB0[r]; _Pragma("unroll") for(int r=0;r<16;++r)sacc+=pB1[r]; l_reg+=sacc;
    pw0=(u32x4){PKW(pB0,0),PKW(pB0,2),PKW(pB0,4),PKW(pB0,6)};pw1=(u32x4){PKW(pB0,8),PKW(pB0,10),PKW(pB0,12),PKW(pB0,14)};pw2=(u32x4){PKW(pB1,0),PKW(pB1,2),PKW(pB1,4),PKW(pB1,6)};pw3=(u32x4){PKW(pB1,8),PKW(pB1,10),PKW(pB1,12),PKW(pB1,14)};
    SBAR(); pv(o,vb0+sl_cur,PAF(0),PAF(1),PAF(2),PAF(3)); }
  #undef PKW
  #undef PAF
  #undef VFR
  #undef PIN
  #undef MX3
  #undef GAPA
  #undef GAPB
  #undef EX
  #undef VRD
  #undef KRD
  #undef STEP
  #undef ENDW
  {auto rr=__builtin_amdgcn_permlane32_swap(__float_as_uint(l_reg),__float_as_uint(l_reg),false,false);l_reg=__uint_as_float(rr[0])+__uint_as_float(rr[1]);}
  if(hi==0)wsf[32+r32]=l_reg;asm volatile("s_waitcnt lgkmcnt(0)":::"memory");
  float rli[16];
  #pragma unroll
  for(int r=0;r<16;++r)rli[r]=__builtin_amdgcn_rcpf(wsf[32+crow(r,hi)]);
  bf16*Ow=O+(rowbase+q0+wid*QBLK)*OP+h*D;
  { bf16*stg=(bf16*)(shm+LDS_OST)+wid*2048;
    #pragma unroll
    for(int r=0;r<16;++r){const int orow=crow(r,hi);
      #pragma unroll
      for(int d0=0;d0<2;++d0)stg[orow*64+d0*32+r32]=__float2bfloat16(o[d0][r]*rli[r]);}
    asm volatile("s_waitcnt lgkmcnt(0)":::"memory");
    #pragma unroll
    for(int i=0;i<4;++i){const int row=i*8+(lane>>3),ch=lane&7; const u32x4 v=*(const u32x4*)(stg+row*64+ch*8); ATTN_STORE16(Ow+(long)row*OP+ch*8,v);} }
  asm volatile("s_waitcnt lgkmcnt(0)\n\ts_barrier":::"memory");
  #undef DMA_K
  #undef DMA_V
  #undef CMASK
  #undef START
  #undef RESC
  #undef ROT
}
constexpr int ATTN_LDS_BYTES=LDS_BYTES;
struct AttnTensors { const bf16* Q; const bf16* K; const bf16* V; bf16* O; };
struct AttnUnit { int b; int h; int qb; };
struct StaticOrder {
  int vcu;
  __device__ __forceinline__ explicit StaticOrder(int vcu_):vcu(vcu_){}
  __device__ __forceinline__ bool next(int i,AttnUnit&u)const{ if(i>=2)return false; const int pr=vcu>>5, lc=vcu&31; u.b=pr>>1; u.h=(pr&1)*4+(lc>>3); u.qb=(lc&7)*2+i; return true; }
};
template<int THRL=8> __device__ __forceinline__ void attn_phase(char*lds,const AttnTensors&T,const StaticOrder&S){
  AttnUnit u;
  for(int i=0;S.next(i,u);++i){ attn_unit<THRL>(u.b,u.h,u.qb,T.Q,T.K,T.V,T.O,lds); }
}
#undef SBAR
#undef WAIT_BAR
}
#define GAS __attribute__((address_space(1)))
#define LAS __attribute__((address_space(3)))
typedef unsigned short bf16;
typedef unsigned v4u __attribute__((ext_vector_type(4)));
typedef float f32x4 __attribute__((ext_vector_type(4)));
typedef short bf16x8 __attribute__((ext_vector_type(8)));
typedef GAS unsigned gu32;
typedef GAS unsigned long long gu64;
#define RLX_AGENT __ATOMIC_RELAXED, __HIP_MEMORY_SCOPE_AGENT
#define LDS_WAIT() asm volatile("s_waitcnt lgkmcnt(0)" ::: "memory")
#define VM_WAIT() asm volatile("s_waitcnt vmcnt(0)" ::: "memory")
__device__ __forceinline__ unsigned long long rt() { return __builtin_amdgcn_s_memrealtime(); }
__device__ __forceinline__ unsigned pk2(float lo, float hi) { return f2bf(lo) | (f2bf(hi) << 16); }

#define XB_TMO      128
#define XB_XCNT(j)  (256  + 64 * (j))
#define XB_XSUB(j)  (1280 + 64 * (j))
#define XB_XGEN(j)  (2304 + 64 * (j))
#define XB_TOP      3328
#define XB_TOPGEN   3392
#define XCD_BAR_WORDS 3456
#define XB_SPIN_CAP (1u << 18)

__device__ __forceinline__ unsigned xb_ld(unsigned* p)              { return __hip_atomic_load(p, __ATOMIC_RELAXED, __HIP_MEMORY_SCOPE_AGENT); }
__device__ __forceinline__ unsigned xb_add(unsigned* p, unsigned v) { return __hip_atomic_fetch_add(p, v, __ATOMIC_RELAXED, __HIP_MEMORY_SCOPE_AGENT); }
__device__ __forceinline__ unsigned xb_xcc_id() { return (unsigned)__builtin_amdgcn_s_getreg((3 << 11) | 20) & 0xFu; }
#define XB_SPIN(cond, bar) do { unsigned _sp = 0; while (cond) { __builtin_amdgcn_s_sleep(1); \
    if ((++_sp & 255u) == 0u) { if (xb_ld(&(bar)[XB_TMO])) break; if (_sp > XB_SPIN_CAP) { atomicAdd(&(bar)[XB_TMO], 1u); break; } } } } while (0)

struct XcdBarrier {
    unsigned* bar; unsigned x;
    volatile LAS unsigned* st;
};

__device__ __forceinline__ XcdBarrier xcd_barrier_post(unsigned* bar, volatile LAS unsigned* st) {
    XcdBarrier b; b.bar = bar; b.x = xb_xcc_id(); b.st = st;
    if (threadIdx.x == 0) (void)xb_add(&bar[XB_XCNT(b.x)], 1u);
    return b;
}
__device__ __forceinline__ void xcd_barrier_complete(unsigned* bar, unsigned x, unsigned& nloc, unsigned& nx) {
    const unsigned G = gridDim.x * gridDim.y * gridDim.z;
    unsigned sum, cnt, mine, sp = 0u;
    for (;;) {
        sum = 0u; cnt = 0u; mine = 0u;
#pragma unroll
        for (unsigned j = 0; j < 16; ++j) { const unsigned c = xb_ld(&bar[XB_XCNT(j)]); sum += c; cnt += (c > 0u) ? 1u : 0u; mine = (j == x) ? c : mine; }
        if (sum == G) break;
        __builtin_amdgcn_s_sleep(1);
        if ((++sp & 255u) == 0u) { if (xb_ld(&bar[XB_TMO])) break; if (sp > XB_SPIN_CAP) { atomicAdd(&bar[XB_TMO], 1u); break; } }
    }
    nloc = mine > 0u ? mine : 1u; nx = cnt > 0u ? cnt : 1u;
}

__device__ __forceinline__ void xcd_barrier(const XcdBarrier& b) {
    asm volatile("s_waitcnt vmcnt(0)" ::: "memory");
    __syncthreads();
    if (threadIdx.x == 0) {
        unsigned* bar = b.bar;
        __builtin_amdgcn_s_waitcnt(0);
        unsigned nloc = b.st[0], nx = b.st[1];
        if (nloc == 0u) { xcd_barrier_complete(bar, b.x, nloc, nx); b.st[0] = nloc; b.st[1] = nx; }
        const unsigned old = xb_add(&bar[XB_XSUB(b.x)], 1u);
        const unsigned gen = old / nloc;
        if (old + 1u == (gen + 1u) * nloc) {
            __builtin_amdgcn_fence(__ATOMIC_RELEASE, "agent");
            asm volatile("s_waitcnt vmcnt(0)" ::: "memory");
            const unsigned og = xb_add(&bar[XB_TOP], 1u);
            const unsigned tg = og / nx;
            if (og + 1u == (tg + 1u) * nx) xb_add(&bar[XB_TOPGEN], 1u);
            else XB_SPIN(xb_ld(&bar[XB_TOPGEN]) == tg, bar);
            __builtin_amdgcn_fence(__ATOMIC_ACQUIRE, "agent");
            xb_add(&bar[XB_XGEN(b.x)], 1u);
            asm volatile("s_waitcnt vmcnt(0)" ::: "memory");
        } else {
            XB_SPIN(xb_ld(&bar[XB_XGEN(b.x)]) == gen, bar);
            __builtin_amdgcn_fence(__ATOMIC_ACQUIRE, "agent");
            asm volatile("s_waitcnt vmcnt(0)" ::: "memory");
        }
    }
    __syncthreads();
}
constexpr int NWAVES = 8;
constexpr int RING_OFF = 0, RING_BYTES = 131072;
constexpr int LDSCTL_OFF = RING_BYTES, MISC_OFF = LDSCTL_OFF + 320;
constexpr int LDS_BYTES = 147456;
constexpr int CW_BAR = 4096;
static_assert((CW_BAR + 8 * XCD_BAR_WORDS) * 4 <= (int)CTL_ZERO_BYTES, "barrier regions inside the memset");

struct Frame {
    LAS unsigned char* lds;
    volatile LAS unsigned* MISC;
    gu32* ctl;
    int tid, lane, wave, vcu, G;
    const float* in[23]; float* out; unsigned char* ws;
};

__device__ __forceinline__ float wave_sum(float v) {
#pragma unroll
    for (int o = 1; o < 64; o <<= 1) v += __shfl_xor(v, o);
    return v;
}
namespace lru {
typedef float f32x2 __attribute__((ext_vector_type(2)));
constexpr int CH = 64, NCH = SEQ / CH;
constexpr int XCF_STRIDE = 68, XCB_STRIDE = 72;
constexpr int L_AU = 0, L_XCF = 65536, L_XCB = L_XCF + 64 * XCF_STRIDE * 4, L_SUB = L_XCB + 64 * XCB_STRIDE * 2, L_CAR = L_SUB + 4096, L_END = L_CAR + 4096;
static_assert(L_END <= RING_BYTES, "LRU scratch");
constexpr float LOG2E = 1.4426950408889634f;

__device__ __forceinline__ void pass1(Frame& F) {
    const int tid = F.tid, lane = F.lane, w = F.wave;
    LAS unsigned char* sh = F.lds + RING_OFF;
    LAS f32x2* AU = (LAS f32x2*)(sh + L_AU); LAS float* XCF = (LAS float*)(sh + L_XCF); LAS bf16* XCB = (LAS bf16*)(sh + L_XCB);
    LAS f32x2* SUB = (LAS f32x2*)(sh + L_SUB); LAS f32x2* CAR = (LAS f32x2*)(sh + L_CAR);
    unsigned char* ws = F.ws;
    const bf16* XR = (const bf16*)(ws + WS_XR); bf16* SL = (bf16*)(ws + WS_SL); bf16* PF = (bf16*)(ws + WS_PF); bf16* PB = (bf16*)(ws + WS_PBK);
    f32x2* AGG = (f32x2*)(ws + WS_AGG); const bf16* LW = (const bf16*)(ws + WS_LW);
    const int cu = F.vcu & 255, b = cu >> 6, n = (cu >> 3) & 7, oct = cu & 7;
    const int cc = tid & 63, tq = tid >> 6;
    const float* cw = F.in[6];
    const float w0 = cw[n * 64 + cc], w1 = cw[512 + n * 64 + cc], w2 = cw[1024 + n * 64 + cc], w3 = cw[1536 + n * 64 + cc], cbv = F.in[7][n * 64 + cc];
    const int ge = w >> 2, gj = (w & 3) * 16 + (lane & 15), gq = lane >> 4, gc = ge * 512 + n * 64 + gj;
    const float bav = F.in[9][gc], bxv = F.in[11][gc];
    const float k8 = 8.0f * (-log1pf(expf(-F.in[12][gc]))) * LOG2E;
    bf16x8 bfr[2][2];
#pragma unroll
    for (int g = 0; g < 2; ++g)
#pragma unroll
        for (int ks = 0; ks < 2; ++ks) bfr[g][ks] = *(const bf16x8*)(LW + ((size_t)(n * 256 + ge * 128 + g * 64 + gj)) * 64 + ks * 32 + 8 * gq);
    const int sc = tid & 63, se = (tid >> 6) & 1, ssub = tid >> 7, scol = se * 64 + sc;
    for (int ci = 0; ci < 8; ++ci) {
        const int chunk = oct * 8 + ci, t0 = chunk * CH; const size_t row0 = (size_t)b * SEQ + t0;
        __syncthreads();
        {
            float xv[11];
#pragma unroll
            for (int r = 0; r < 11; ++r) { const int tt = t0 + tq * 8 - 2 + r; xv[r] = (tt >= 0 && tt < SEQ) ? bf2f(XR[((size_t)b * SEQ + tt) * DLRU + n * 64 + cc]) : 0.f; }
#pragma unroll
            for (int i = 0; i < 8; ++i) { const float xc = cbv + w0 * xv[i] + w1 * xv[i + 1] + w2 * xv[i + 2] + w3 * xv[i + 3]; const int t = tq * 8 + i;
                XCF[t * XCF_STRIDE + cc] = xc; XCB[t * XCB_STRIDE + cc] = (bf16)f2bf(xc); }
        }
        __syncthreads();
#pragma unroll
        for (int mb = 0; mb < 4; ++mb) {
            const LAS bf16* ap = XCB + (16 * mb + (lane & 15)) * XCB_STRIDE + 8 * gq;
            const bf16x8 a0 = *(const LAS bf16x8*)(ap), a1 = *(const LAS bf16x8*)(ap + 32);
            f32x4 ga = {0.f, 0.f, 0.f, 0.f}, gx = {0.f, 0.f, 0.f, 0.f};
            ga = __builtin_amdgcn_mfma_f32_16x16x32_bf16(a0, bfr[0][0], ga, 0, 0, 0); ga = __builtin_amdgcn_mfma_f32_16x16x32_bf16(a1, bfr[0][1], ga, 0, 0, 0);
            gx = __builtin_amdgcn_mfma_f32_16x16x32_bf16(a0, bfr[1][0], gx, 0, 0, 0); gx = __builtin_amdgcn_mfma_f32_16x16x32_bf16(a1, bfr[1][1], gx, 0, 0, 0);
#pragma unroll
            for (int r = 0; r < 4; ++r) {
                const int t = 16 * mb + 4 * gq + r; const float xc = XCF[t * XCF_STRIDE + gj];
                const float rg = __builtin_amdgcn_rcpf(1.0f + __builtin_amdgcn_exp2f(-LOG2E * (ga[r] + bav)));
                const float ig = __builtin_amdgcn_rcpf(1.0f + __builtin_amdgcn_exp2f(-LOG2E * (gx[r] + bxv)));
                const float a = __builtin_amdgcn_exp2f(k8 * rg);
                const float u = __builtin_amdgcn_sqrtf(fmaxf(fmaf(-a, a, 1.0f), 0.f)) * (ig * xc);
                AU[t * 128 + ge * 64 + gj] = (f32x2){a, u};
            }
        }
        __syncthreads();
        {
            float P = 1.f, h = 0.f;
#pragma unroll
            for (int i = 0; i < 16; ++i) { const int t = se == 0 ? 16 * ssub + i : 16 * ssub + 15 - i; const f32x2 au = AU[t * 128 + scol]; h = au.x * h + au.y; P *= au.x; AU[t * 128 + scol] = (f32x2){P, h}; }
            SUB[ssub * 128 + scol] = (f32x2){P, h};
        }
        __syncthreads();
        {
            float cin = 0.f, pin = 1.f;
            if (se == 0) { for (int s2 = 0; s2 < ssub; ++s2) { const f32x2 ph = SUB[s2 * 128 + scol]; cin = ph.x * cin + ph.y; pin *= ph.x; } }
            else { for (int s2 = 3; s2 > ssub; --s2) { const f32x2 ph = SUB[s2 * 128 + scol]; cin = ph.x * cin + ph.y; pin *= ph.x; } }
            CAR[ssub * 128 + scol] = (f32x2){pin, cin};
            if ((se == 0 && ssub == 3) || (se == 1 && ssub == 0)) { const f32x2 ph = SUB[ssub * 128 + scol];
                AGG[((size_t)(b * NCH + chunk) * 2 + se) * DLRU + n * 64 + sc] = (f32x2){pin * ph.x, ph.y + ph.x * cin}; }
        }
        __syncthreads();
        {
            const int cp = tid & 31;
#pragma unroll
            for (int ps = 0; ps < 4; ++ps) {
                const int t = ps * 16 + (tid >> 5), sub = t >> 4;
                const f32x4 f = *(const LAS f32x4*)(AU + t * 128 + 2 * cp), bk = *(const LAS f32x4*)(AU + t * 128 + 64 + 2 * cp);
                const f32x4 cf = *(const LAS f32x4*)(CAR + sub * 128 + 2 * cp), cb = *(const LAS f32x4*)(CAR + sub * 128 + 64 + 2 * cp);
                const float hf0 = f[1] + f[0] * cf[1], hf1 = f[3] + f[2] * cf[3], pf0 = f[0] * cf[0], pf1 = f[2] * cf[2];
                const float hb0 = bk[1] + bk[0] * cb[1], hb1 = bk[3] + bk[2] * cb[3], pb0 = bk[0] * cb[0], pb1 = bk[2] * cb[2];
                const size_t o = (row0 + t) * DLRU + n * 64 + 2 * cp;
                *(unsigned*)(SL + o) = pk2(hf0 + hb0, hf1 + hb1); *(unsigned*)(PF + o) = pk2(pf0, pf1); *(unsigned*)(PB + o) = pk2(pb0, pb1);
            }
        }
    }
    __syncthreads();
}

__device__ __forceinline__ f32x4 lo4(const v4u w) { f32x4 v; v[0] = __uint_as_float(w.x << 16); v[1] = __uint_as_float(w.x & 0xffff0000u); v[2] = __uint_as_float(w.y << 16); v[3] = __uint_as_float(w.y & 0xffff0000u); return v; }
__device__ __forceinline__ f32x4 hi4(const v4u w) { f32x4 v; v[0] = __uint_as_float(w.z << 16); v[1] = __uint_as_float(w.z & 0xffff0000u); v[2] = __uint_as_float(w.w << 16); v[3] = __uint_as_float(w.w & 0xffff0000u); return v; }
__device__ __forceinline__ float sum8sq(const f32x4 a, const f32x4 b) { return ((a[0] * a[0] + a[1] * a[1]) + (a[2] * a[2] + a[3] * a[3])) + ((b[0] * b[0] + b[1] * b[1]) + (b[2] * b[2] + b[3] * b[3])); }
__device__ __forceinline__ v4u pack8(const f32x4 a, const f32x4 b) { v4u o; o.x = pk2(a[0], a[1]); o.y = pk2(a[2], a[3]); o.z = pk2(b[0], b[1]); o.w = pk2(b[2], b[3]); return o; }

template <bool ATT_HALF> __device__ __forceinline__ void pass2(Frame& F) {
    const int tid = F.tid;
    LAS unsigned char* sh = F.lds + RING_OFF;
    LAS f32x2* CFB = (LAS f32x2*)sh;
    unsigned char* ws = F.ws;
    const bf16* SL = (const bf16*)(ws + WS_SL); const bf16* PF = (const bf16*)(ws + WS_PF); const bf16* PB = (const bf16*)(ws + WS_PBK); const bf16* XG = (const bf16*)(ws + WS_XG);
    bf16* Y = (bf16*)(ws + WS_Y); const f32x2* AGG = (const f32x2*)(ws + WS_AGG);
    const float* gat = F.in[13]; const float* gl = F.in[14];
    const int cu = F.vcu & 255, b = cu >> 6, chunk = cu & 63; const size_t row0 = (size_t)b * SEQ + chunk * CH;
    {
        float cf = 0.f, cb = 0.f;
        for (int k = 0; k < chunk; ++k) { const f32x2 ah = AGG[((size_t)(b * NCH + k) * 2 + 0) * DLRU + tid]; cf = ah.x * cf + ah.y; }
        for (int k = NCH - 1; k > chunk; --k) { const f32x2 ah = AGG[((size_t)(b * NCH + k) * 2 + 1) * DLRU + tid]; cb = ah.x * cb + ah.y; }
        CFB[tid] = (f32x2){cf, cb};
    }
    __syncthreads();
    const int t = tid >> 3, l8 = tid & 7; const size_t row = row0 + t;
    {
        f32x4 y[8][2]; float s = 0.f;
#pragma unroll
        for (int k = 0; k < 8; ++k) {
            const int c0 = (l8 + 8 * k) * 8; const size_t o = row * DLRU + c0;
            const v4u sl = *(const GAS v4u*)(SL + o), pf = *(const GAS v4u*)(PF + o), pb = *(const GAS v4u*)(PB + o), xg = *(const GAS v4u*)(XG + o);
            const f32x4 c01 = *(const LAS f32x4*)(CFB + c0), c23 = *(const LAS f32x4*)(CFB + c0 + 2), c45 = *(const LAS f32x4*)(CFB + c0 + 4), c67 = *(const LAS f32x4*)(CFB + c0 + 6);
            const f32x4 cfl = {c01[0], c01[2], c23[0], c23[2]}, cbl = {c01[1], c01[3], c23[1], c23[3]}, cfh = {c45[0], c45[2], c67[0], c67[2]}, cbh = {c45[1], c45[3], c67[1], c67[3]};
            y[k][0] = (lo4(sl) + lo4(pf) * cfl + lo4(pb) * cbl) * lo4(xg); y[k][1] = (hi4(sl) + hi4(pf) * cfh + hi4(pb) * cbh) * hi4(xg);
            s += sum8sq(y[k][0], y[k][1]);
        }
        s += __shfl_xor(s, 1); s += __shfl_xor(s, 2); s += __shfl_xor(s, 4);
        const float rn = rsqrtf(s * (1.0f / DLRU) + EPS);
#pragma unroll
        for (int k = 0; k < 8; ++k) {
            const int c0 = (l8 + 8 * k) * 8; const f32x4 g0 = *(const f32x4*)(gl + c0), g1 = *(const f32x4*)(gl + c0 + 4);
            *(GAS v4u*)(Y + row * DM + DATT + c0) = pack8(y[k][0] * rn * g0, y[k][1] * rn * g1);
        }
    }
    if (ATT_HALF) {
        f32x4 y[8][2]; float s = 0.f;
#pragma unroll
        for (int k = 0; k < 8; ++k) { const int c0 = (l8 + 8 * k) * 8; const v4u v = *(const GAS v4u*)(Y + row * DM + c0); y[k][0] = lo4(v); y[k][1] = hi4(v); s += sum8sq(y[k][0], y[k][1]); }
        s += __shfl_xor(s, 1); s += __shfl_xor(s, 2); s += __shfl_xor(s, 4);
        const float rn = rsqrtf(s * (1.0f / DATT) + EPS);
#pragma unroll
        for (int k = 0; k < 8; ++k) {
            const int c0 = (l8 + 8 * k) * 8; const f32x4 g0 = *(const f32x4*)(gat + c0), g1 = *(const f32x4*)(gat + c0 + 4);
            *(GAS v4u*)(Y + row * DM + c0) = pack8(y[k][0] * rn * g0, y[k][1] * rn * g1);
        }
    }
    __syncthreads();
}
}

__device__ __forceinline__ int win_rowmap(int L) {
    const int tile = L >> 8, l = L & 255; int p;
    if (tile < 3) p = (((l >> 5) & 1) << 7) | ((l >> 6) << 5) | (l & 31);
    else { const int lo = l & 31; p = (l & ~31) | (((lo >> 2) & 1) << 4) | ((lo >> 3) << 2) | (lo & 3); }
    return tile * 256 + p;
}
template <bool MAP>
__device__ __forceinline__ void p0_transpose_item(const float* W, int K, int N, bf16* WT, const float* g, LAS float* scr, int item, int lane) {
    const int nblk = N / 32, kb = item / nblk, nb = item % nblk, k0 = 64 * kb, n0 = 32 * nb;
#pragma unroll 8
    for (int i = 0; i < 32; ++i) { const int kk = 2 * i + (lane >> 5); float v = W[(size_t)(k0 + kk) * N + n0 + (lane & 31)]; if (g) v *= g[k0 + kk]; scr[kk * 33 + (lane & 31)] = v; }
    LDS_WAIT(); asm volatile("" ::: "memory");
    const int c = lane & 7;
#pragma unroll
    for (int j = 0; j < 4; ++j) { const int n = (lane >> 3) + 8 * j; const LAS float* s = scr + (8 * c) * 33 + n;
        v4u o; o.x = pk2(s[0 * 33], s[1 * 33]); o.y = pk2(s[2 * 33], s[3 * 33]); o.z = pk2(s[4 * 33], s[5 * 33]); o.w = pk2(s[6 * 33], s[7 * 33]);
        const int row = MAP ? win_rowmap(n0 + n) : (n0 + n);
        *(GAS v4u*)(WT + (size_t)row * K + k0 + 8 * c) = o; }
    LDS_WAIT(); asm volatile("" ::: "memory");
}
__device__ __forceinline__ void p0_prologue(Frame& F) {
    LAS float* scr = (LAS float*)(F.lds + RING_OFF + F.wave * 16384);
    const int gw = F.vcu * NWAVES + F.wave, NGW = F.G * NWAVES;
    constexpr int I_IN = (DM / 64) * (DIN / 32), I_OUT = (DM / 64) * (DM / 32), I_UP = (DM / 64) * (DFF / 32), I_DN = (DFF / 64) * (DM / 32), I_G = I_OUT, I_P = (DPLE / 64) * (DM / 32);
    constexpr int NITEMS = I_IN + I_OUT + I_UP + I_DN + I_G + I_P;
    unsigned char* ws = F.ws;
    for (int it = gw; it < NITEMS; it += NGW) {
        int r = it;
        if (r < I_IN) { p0_transpose_item<true>(F.in[3], DM, DIN, (bf16*)(ws + WS_WIN), F.in[2], scr, r, F.lane); continue; } r -= I_IN;
        if (r < I_OUT) { p0_transpose_item<false>(F.in[15], DM, DM, (bf16*)(ws + WS_WOUT), nullptr, scr, r, F.lane); continue; } r -= I_OUT;
        if (r < I_UP) { p0_transpose_item<false>(F.in[17], DM, DFF, (bf16*)(ws + WS_WUP), F.in[16], scr, r, F.lane); continue; } r -= I_UP;
        if (r < I_DN) { p0_transpose_item<false>(F.in[18], DFF, DM, (bf16*)(ws + WS_WDOWN), nullptr, scr, r, F.lane); continue; } r -= I_DN;
        if (r < I_G) { p0_transpose_item<false>(F.in[20], DM, DM, (bf16*)(ws + WS_WG), F.in[19], scr, r, F.lane); continue; } r -= I_G;
        p0_transpose_item<false>(F.in[21], DPLE, DM, (bf16*)(ws + WS_WP), nullptr, scr, r, F.lane);
    }
    const float* x = F.in[0]; const float* p = F.in[1]; float* RSX = (float*)(ws + WS_RSX); bf16* XB = (bf16*)(ws + WS_HB); bf16* PB = (bf16*)(ws + WS_PB);
    for (int m = gw; m < T; m += NGW) {
        const GAS f32x4* xr = (const GAS f32x4*)(x + (size_t)m * DM) + F.lane;
        f32x4 v[4]; float s = 0.f;
#pragma unroll
        for (int j = 0; j < 4; ++j) { v[j] = xr[64 * j]; s += (v[j].x * v[j].x + v[j].y * v[j].y) + (v[j].z * v[j].z + v[j].w * v[j].w); }
        s = wave_sum(s);
        if (F.lane == 0) RSX[m] = rsqrtf(s * (1.0f / DM) + EPS);
        GAS unsigned long long* o8 = (GAS unsigned long long*)(XB + (size_t)m * DM) + F.lane;
#pragma unroll
        for (int j = 0; j < 4; ++j) o8[64 * j] = (unsigned long long)pk2(v[j].x, v[j].y) | ((unsigned long long)pk2(v[j].z, v[j].w) << 32);
        const f32x4 pv = *((const GAS f32x4*)(p + (size_t)m * DPLE) + F.lane);
        *((GAS unsigned long long*)(PB + (size_t)m * DPLE) + F.lane) = (unsigned long long)pk2(pv.x, pv.y) | ((unsigned long long)pk2(pv.z, pv.w) << 32);
    }
    { bf16* LW = (bf16*)(ws + WS_LW);
      for (int idx = (F.vcu * NWAVES + F.wave) * 64 + F.lane; idx < NBLK * 256 * 64; idx += F.G * NWAVES * 64) {
          const int n = idx >> 14, col = (idx >> 6) & 255, k = idx & 63, e = col >> 7, gsel = (col >> 6) & 1, j = col & 63;
          const float* src = gsel ? F.in[10] : F.in[8]; LW[idx] = (bf16)f2bf(src[(((size_t)e * NBLK + n) * 64 + k) * 64 + j]); } }
    float* rope = (float*)(ws + WS_ROPE);
    for (int idx = (F.vcu * NWAVES + F.wave) * 64 + F.lane; idx < 1024; idx += F.G * NWAVES * 64) {
        const int pos = idx >> 4, i = idx & 15; const float fr = powf(10000.f, -(float)i / 16.f); const float ang = (float)pos * fr;
        rope[idx] = cosf(ang); rope[1024 + idx] = sinf(ang);
    }
}

#ifndef REP
#define REP 0
#endif
#ifndef PHC
#define PHC 0x1ff
#endif
struct Args { const float* in[23]; float* out; unsigned char* ws; int ph_lo, ph_hi, li, flags; };
constexpr int NPHASE = 9;
__global__ void __launch_bounds__(NWAVES * 64, 2) mega(Args args) {
    extern __shared__ __attribute__((aligned(16))) unsigned char lds[];
    Frame F;
    F.lds = (LAS unsigned char*)lds;
    F.MISC = (volatile LAS unsigned*)(F.lds + MISC_OFF);
    F.tid = threadIdx.x; F.lane = F.tid & 63; F.wave = __builtin_amdgcn_readfirstlane(F.tid >> 6);
    F.G = gridDim.x; { const int bx = blockIdx.x; F.vcu = (F.G % 8 == 0) ? (bx % 8) * (F.G / 8) + bx / 8 : bx; }
    unsigned char* ws = args.ws; F.ws = ws; F.out = args.out;
#pragma unroll
    for (int i = 0; i < 23; ++i) F.in[i] = args.in[i];
    F.ctl = (gu32*)(ws + WS_CTL);
    for (int u = F.tid; u < (LDS_BYTES - LDSCTL_OFF) / 4; u += NWAVES * 64) ((LAS unsigned*)(F.lds + LDSCTL_OFF))[u] = 0u;
    __syncthreads();
    const int lo = args.ph_lo, hi = args.ph_hi;
    XcdBarrier bar; bar.bar = (unsigned*)(F.ctl + CW_BAR) + args.li * XCD_BAR_WORDS; bar.x = 0; bar.st = nullptr;
    if (hi - lo > 1) bar = xcd_barrier_post((unsigned*)(F.ctl + CW_BAR) + args.li * XCD_BAR_WORDS, F.MISC + 8);
#define GRID_BAR() xcd_barrier(bar)
#define IN(k) (lo <= (k) && (k) < hi)
#define BOTH(k) (IN(k) && IN((k) + 1))
    bf16* const XB = (bf16*)(ws + WS_HB); bf16* const HB = (bf16*)(ws + WS_HB); bf16* const PB = (bf16*)(ws + WS_PB); bf16* const PP = (bf16*)(ws + WS_PP);
    bf16* const Qb = (bf16*)(ws + WS_Q); bf16* const Kb = (bf16*)(ws + WS_K); bf16* const Vb = (bf16*)(ws + WS_V); bf16* const XR = (bf16*)(ws + WS_XR); bf16* const XG = (bf16*)(ws + WS_XG);
    bf16* const Y = (bf16*)(ws + WS_Y); bf16* const Mb = (bf16*)(ws + WS_M); bf16* const H3B = (bf16*)(ws + WS_H3B);
    float* const RSX = (float*)(ws + WS_RSX); float* const ROPE = (float*)(ws + WS_ROPE);
    float* const SS1 = (float*)(ws + WS_SS1); float* const SS2 = (float*)(ws + WS_SS2); float* const SS3 = (float*)(ws + WS_SS3);

    if ((PHC >> 0 & 1) && IN(0)) { p0_prologue(F);
#if REP & 1
        __syncthreads(); p0_prologue(F);
#endif
        if (BOTH(0)) GRID_BAR(); }

    if ((PHC >> 1 & 1) && IN(1)) {
        { pg8::Gemm g{XB, (const bf16*)(ws + WS_WIN), T, DIN, DM}; pg8::StaticOrder S; S.init(T, DIN, F.G, (int)blockIdx.x);
          pg8::EpiIn E{RSX, F.in[4], F.in[5], ROPE, Qb, Kb, Vb, XR, XG};
          pg8::gemm_phase<pg8::EpiIn, pg8::StaticOrder, PG8_ALIGN, PG8_SP2>(F.lds + RING_OFF, g, S, E);
#if REP & 2
          pg8::gemm_phase<pg8::EpiIn, pg8::StaticOrder, PG8_ALIGN, PG8_SP2>(F.lds + RING_OFF, g, S, E);
#endif
        }
        if (BOTH(1)) GRID_BAR();
    }

    if ((PHC >> 2 & 1) && IN(2)) {
        if (args.flags & 1) {
            const attn_body::AttnTensors AT{(const attn_body::bf16*)Qb, (const attn_body::bf16*)Kb, (const attn_body::bf16*)Vb, (attn_body::bf16*)Y};
            const attn_body::StaticOrder S(F.vcu);
            attn_body::attn_phase<8>((char*)lds + RING_OFF, AT, S);
#if REP & 4
            attn_body::attn_phase<8>((char*)lds + RING_OFF, AT, S);
#endif
        }
        if (args.flags & 2) lru::pass1(F);
#if REP & 8
        if (args.flags & 2) lru::pass1(F);
#endif
#if REP & 512
        for (int rb = 0; rb < 8; ++rb) GRID_BAR();
#endif
        if (BOTH(2)) GRID_BAR();
    }
    if ((PHC >> 3 & 1) && IN(3)) {
        if (args.flags & 4) lru::pass2<true>(F);
#if REP & 16
        if (args.flags & 4) lru::pass2<false>(F);
#endif
        { pg8::Gemm g{PB, (const bf16*)(ws + WS_WP), T, DM, DPLE}; pg8::StaticOrder S; S.init(T, DM, F.G, (int)blockIdx.x);
          pg8::EpiBf16<0> E{PP, DM, nullptr, 0, 0, 1.f};
          pg8::gemm_phase<pg8::EpiBf16<0>, pg8::StaticOrder, PG8_ALIGN, PG8_SP2>(F.lds + RING_OFF, g, S, E);
#if REP & 1024
          pg8::gemm_phase<pg8::EpiBf16<0>, pg8::StaticOrder, PG8_ALIGN, PG8_SP2>(F.lds + RING_OFF, g, S, E);
#endif
        }
        if (BOTH(3)) GRID_BAR();
    }
    if ((PHC >> 4 & 1) && IN(4)) {
        pg8::Gemm g{Y, (const bf16*)(ws + WS_WOUT), T, DM, DM}; pg8::StaticOrder S; S.init(T, DM, F.G, (int)blockIdx.x);
        pg8::EpiRes<true> E{HB, SS1};
        pg8::gemm_phase<pg8::EpiRes<true>, pg8::StaticOrder, PG8_ALIGN, PG8_SP2>(F.lds + RING_OFF, g, S, E);
#if REP & 32
        pg8::gemm_phase<pg8::EpiRes<true>, pg8::StaticOrder, PG8_ALIGN, PG8_SP2>(F.lds + RING_OFF, g, S, E);
#endif
        if (BOTH(4)) GRID_BAR();
    }
    if ((PHC >> 5 & 1) && IN(5)) {
        pg8::Gemm g{HB, (const bf16*)(ws + WS_WUP), T, DFF, DM}; pg8::StaticOrder S; S.init(T, DFF, F.G, (int)blockIdx.x);
        pg8::EpiUp E{SS1, Mb};
        pg8::gemm_phase<pg8::EpiUp, pg8::StaticOrder, PG8_ALIGN, PG8_SP2>(F.lds + RING_OFF, g, S, E);
#if REP & 64
        pg8::gemm_phase<pg8::EpiUp, pg8::StaticOrder, PG8_ALIGN, PG8_SP2>(F.lds + RING_OFF, g, S, E);
#endif
        if (BOTH(5)) GRID_BAR();
    }
    if ((PHC >> 6 & 1) && IN(6)) {
        pg8::Gemm g{Mb, (const bf16*)(ws + WS_WDOWN), T, DM, DFF}; pg8::StaticOrder S; S.init(T, DM, F.G, (int)blockIdx.x);
#if REP & 128
        { pg8::EpiRes<false> E0{HB, SS2}; pg8::gemm_phase<pg8::EpiRes<false>, pg8::StaticOrder, PG8_ALIGN, PG8_SP2>(F.lds + RING_OFF, g, S, E0); }
#endif
        pg8::EpiRes<true> E{HB, SS2};
        pg8::gemm_phase<pg8::EpiRes<true>, pg8::StaticOrder, PG8_ALIGN, PG8_SP2>(F.lds + RING_OFF, g, S, E);
        if (BOTH(6)) GRID_BAR();
    }
    if ((PHC >> 7 & 1) && IN(7)) {
        pg8::Gemm g{HB, (const bf16*)(ws + WS_WG), T, DM, DM}; pg8::StaticOrder S; S.init(T, DM, F.G, (int)blockIdx.x);
#if REP & 256
        { pg8::EpiGate<false> E0{SS2, PP, HB, H3B, SS3}; pg8::gemm_phase<pg8::EpiGate<false>, pg8::StaticOrder, PG8_ALIGN, PG8_SP2>(F.lds + RING_OFF, g, S, E0); }
#endif
        pg8::EpiGate<true> E{SS2, PP, HB, H3B, SS3};
        pg8::gemm_phase<pg8::EpiGate<true>, pg8::StaticOrder, PG8_ALIGN, PG8_SP2>(F.lds + RING_OFF, g, S, E);
        if (BOTH(7)) GRID_BAR();
    }
    if ((PHC >> 8 & 1) && IN(8)) {
        const int gw = F.vcu * NWAVES + F.wave, NGW = F.G * NWAVES; const float* gf = F.in[22];
        for (int m = gw; m < T; m += NGW) {
            const float rs = pg8::rstd16(SS3 + (size_t)m * 16);
            GAS f32x4* o = (GAS f32x4*)(F.out + (size_t)m * DM) + F.lane; const GAS unsigned long long* hsrc = (const GAS unsigned long long*)(H3B + (size_t)m * DM) + F.lane;
#pragma unroll
            for (int j = 0; j < 4; ++j) { const f32x4 gv = *((const GAS f32x4*)gf + F.lane + 64 * j); const unsigned long long hw = hsrc[64 * j];
                f32x4 v; v[0] = __uint_as_float((unsigned)hw << 16); v[1] = __uint_as_float((unsigned)hw & 0xffff0000u); v[2] = __uint_as_float((unsigned)(hw >> 32) << 16); v[3] = __uint_as_float((unsigned)(hw >> 32) & 0xffff0000u);
                o[64 * j] = v * rs * gv; }
        }
    }
#undef IN
#undef BOTH
#undef GRID_BAR
}

#ifndef MEGA_MASK
#define MEGA_MASK 0x01
#endif
extern "C" void kernel_launch(void* const* d_in, const int* in_sizes, int n_in, void* d_out, int out_size, void* d_ws, size_t ws_size, hipStream_t stream) {
    static int grid = 0;
    if (grid == 0) {
        if (n_in != 23 || in_sizes[0] != T * DM || out_size != T * DM || ws_size < WS_END) { fprintf(stderr, "kernel_launch: unexpected shapes (n_in %d, in0 %d, out %d, ws %zu)\n", n_in, n_in > 0 ? in_sizes[0] : -1, out_size, ws_size); grid = -1; return; }
        int dev = 0, cus = 0, per_cu = 0;
        if (hipGetDevice(&dev) != hipSuccess || hipDeviceGetAttribute(&cus, hipDeviceAttributeMultiprocessorCount, dev) != hipSuccess) { grid = -1; return; }
        if (hipFuncSetAttribute((const void*)mega, hipFuncAttributeMaxDynamicSharedMemorySize, LDS_BYTES) != hipSuccess) { fprintf(stderr, "kernel_launch: hipFuncSetAttribute failed\n"); grid = -1; return; }
        if (hipOccupancyMaxActiveBlocksPerMultiprocessor(&per_cu, (const void*)mega, NWAVES * 64, LDS_BYTES) != hipSuccess || per_cu < 1) { fprintf(stderr, "kernel_launch: occupancy query says %d blocks per CU\n", per_cu); (void)hipGetLastError(); grid = -1; return; }
        grid = cus;
        if (grid != 256) fprintf(stderr, "kernel_launch: %d CUs; this kernel's unit maps assume 256\n", grid);
    }
    if (grid < 0) return;
    const float* in[23]; for (int i = 0; i < 23; ++i) in[i] = (const float*)d_in[i];
    unsigned char* ws = (unsigned char*)d_ws; float* out = (float*)d_out;
    (void)hipMemsetAsync(ws + WS_CTL, 0, CTL_ZERO_BYTES, stream);
    Args a{}; for (int i = 0; i < 23; ++i) a.in[i] = in[i]; a.out = out; a.ws = ws;
    int li = 0;
    auto launch = [&](int lo, int hi, int flags) {
        a.ph_lo = lo; a.ph_hi = hi; a.li = li++; a.flags = flags;
        if (hi - lo > 1) { void* kargs[] = {(void*)&a}; hipError_t e = hipLaunchCooperativeKernel((const void*)mega, dim3(grid), dim3(NWAVES * 64), kargs, LDS_BYTES, stream);
            if (e != hipSuccess) fprintf(stderr, "kernel_launch: cooperative launch failed: %s\n", hipGetErrorString(e)); }
        else hipLaunchKernelGGL(mega, dim3(grid), dim3(NWAVES * 64), LDS_BYTES, stream, a);
    };
    constexpr int MM = MEGA_MASK;
    if (MM == 0x7f) { launch(0, NPHASE, 7); return; }
    bf16_t* Q = (bf16_t*)(ws + WS_Q); bf16_t* K = (bf16_t*)(ws + WS_K); bf16_t* V = (bf16_t*)(ws + WS_V); bf16_t* XR = (bf16_t*)(ws + WS_XR); bf16_t* XG = (bf16_t*)(ws + WS_XG);
    bf16_t* Y = (bf16_t*)(ws + WS_Y); bf16_t* M = (bf16_t*)(ws + WS_M);
    float* HF = out; float* HBs = out + (size_t)T * DLRU;
    if (MM & 0x01) launch(0, 2, 0); else nv::s1<<<T / 4, 256, 0, stream>>>(in[0], in[2], in[3], in[4], in[5], Q, K, V, XR, XG);
    if (MM & 0x02) launch(2, 3, 1); else nv::attn<<<dim3(SEQ / 128, NQH, BATCH), 128, 0, stream>>>(Q, K, V, Y);
    if (MM & 0x04) { launch(2, 3, 2); launch(3, 4, 4); }
    else { nv::lru<<<BATCH * NBLK, 128, 0, stream>>>(XR, in[6], in[7], in[8], in[9], in[10], in[11], in[12], HF, HBs); nv::merge<<<T, 256, 0, stream>>>(Y, HF, HBs, XG, in[13], in[14]);
           if (MM & 0x40) launch(3, 4, 0); }
    if (MM & 0x08) launch(4, 5, 0); else nv::s4<<<T / 4, 256, 0, stream>>>(in[0], Y, in[15], out);
    if (MM & 0x10) launch(5, 6, 0); else nv::s5<<<T / 4, 256, 0, stream>>>(out, in[16], in[17], M);
    if (MM & 0x20) launch(6, 7, 0); else nv::s6<<<T / 4, 256, 0, stream>>>(out, M, in[18]);
    if (MM & 0x40) launch(7, 9, 0); else nv::s7<<<T / 4, 256, 0, stream>>>(out, in[1], in[19], in[20], in[21], in[22]);
}
```

```cpp
#include <hip/hip_runtime.h>
#include <cstdio>
#include <cstdint>

constexpr int BATCH = 4, SEQ = 4096, DM = 1024, T = BATCH * SEQ;
constexpr int DATT = 512, NQH = 8, NKVH = 2, HD = 64, DKV = 128, DLRU = 512, NBLK = 8, BW = 64;
constexpr int DIN = 1792, DFF = 4096, DPLE = 256, GRIDW = 64;
constexpr float EPS = 1e-6f;
constexpr float C2 = 0.125f * 1.4426950408889634f;

typedef unsigned short bf16_t;
__device__ __forceinline__ unsigned f2bf(float f) { unsigned u = __float_as_uint(f); return (u + 0x7fffu + ((u >> 16) & 1u)) >> 16; }
__device__ __forceinline__ float bf2f(bf16_t h) { return __uint_as_float(((unsigned)h) << 16); }

constexpr size_t MiB = 1u << 20, KiB = 1u << 10;
constexpr size_t WS_CTL = 0, CTL_ZERO_BYTES = 128 * KiB;
constexpr size_t WS_ROPE = 1 * MiB;
constexpr size_t WS_RSX = 1 * MiB + 64 * KiB;
constexpr size_t WS_LW = 1 * MiB + 512 * KiB;
constexpr size_t WS_SS1 = 2 * MiB, WS_SS2 = 3 * MiB, WS_SS3 = 4 * MiB;
constexpr size_t WS_AGG = 5 * MiB;
constexpr size_t WS_WIN = 7 * MiB;
constexpr size_t WS_WOUT = WS_WIN + 3584 * KiB;
constexpr size_t WS_WUP = WS_WOUT + 2 * MiB;
constexpr size_t WS_WDOWN = WS_WUP + 8 * MiB;
constexpr size_t WS_WG = WS_WDOWN + 8 * MiB;
constexpr size_t WS_WP = WS_WG + 2 * MiB;
static_assert(WS_WP + 512 * KiB <= 32 * MiB, "weights");
constexpr size_t WS_PP = 32 * MiB;
constexpr size_t WS_HB = 64 * MiB;
constexpr size_t WS_PB = 96 * MiB;
constexpr size_t WS_H3B = 96 * MiB;
constexpr size_t WS_K = 104 * MiB;
constexpr size_t WS_V = 108 * MiB;
constexpr size_t WS_Q = 112 * MiB;
constexpr size_t WS_M = 128 * MiB;
constexpr size_t WS_XR = 128 * MiB;
constexpr size_t WS_XG = 144 * MiB;
constexpr size_t WS_Y = 160 * MiB;
constexpr size_t WS_SL = 192 * MiB;
constexpr size_t WS_PF = 208 * MiB;
constexpr size_t WS_PBK = 224 * MiB;
constexpr size_t WS_END = 256 * MiB;

#define MEGA_MASK 0x7f
#define REP 0
namespace nv {
__device__ __forceinline__ float block_sum(float v, float* red) {
    for (int o = 32; o > 0; o >>= 1) v += __shfl_xor(v, o);
    __syncthreads();
    if ((threadIdx.x & 63) == 0) red[threadIdx.x >> 6] = v;
    __syncthreads();
    const int nw = blockDim.x >> 6; float s = 0.f;
    for (int i = 0; i < nw; ++i) s += red[i];
    return s;
}
__device__ __forceinline__ float gelu_tanh(float x) { const float u = 0.7978845608028654f * (x + 0.044715f * x * x * x); return 0.5f * x * (1.f + tanhf(u)); }
__device__ __forceinline__ float sigmoidf(float x) { return 1.f / (1.f + expf(-x)); }

__device__ __forceinline__ void dot4(const float* As, int K, const float* __restrict__ W, int N, int col, float acc[4]) {
    for (int k = 0; k < K; ++k) { const float w = W[(size_t)k * N + col]; const float4 a = *(const float4*)(As + 4 * k);
        acc[0] += a.x * w; acc[1] += a.y * w; acc[2] += a.z * w; acc[3] += a.w * w; }
}

__global__ void __launch_bounds__(256) s1(const float* __restrict__ x, const float* __restrict__ g, const float* __restrict__ w_in, const float* __restrict__ qn, const float* __restrict__ kn,
                                          bf16_t* Q, bf16_t* K, bf16_t* V, bf16_t* XR, bf16_t* XG) {
    __shared__ float As[DM * 4]; __shared__ float zs[4][DIN]; __shared__ float red[4]; __shared__ float rs[4];
    const int tid = threadIdx.x, t0 = blockIdx.x * 4;
    for (int r = 0; r < 4; ++r) { float s = 0.f; for (int i = tid; i < DM; i += 256) { const float v = x[(size_t)(t0 + r) * DM + i]; s += v * v; }
        s = block_sum(s, red); if (tid == 0) rs[r] = rsqrtf(s / DM + EPS); }
    __syncthreads();
    for (int i = tid; i < DM * 4; i += 256) { const int k = i >> 2, r = i & 3; As[i] = x[(size_t)(t0 + r) * DM + k] * rs[r] * g[k]; }
    __syncthreads();
    for (int j = 0; j < DIN / 256; ++j) { const int col = tid + 256 * j; float acc[4] = {0.f, 0.f, 0.f, 0.f}; dot4(As, DM, w_in, DIN, col, acc);
        for (int r = 0; r < 4; ++r) zs[r][col] = acc[r]; }
    __syncthreads();
    for (int it = tid; it < 4 * 10 * 16; it += 256) {
        const int i = it & 15, hh = (it >> 4) % 10, r = it / 160, t = t0 + r, pos = t % SEQ;
        const float* zh = &zs[r][hh < 8 ? hh * 64 : DATT + (hh - 8) * 64];
        float ss = 0.f; for (int d = 0; d < 64; ++d) ss += zh[d] * zh[d];
        const float rn = rsqrtf(ss / 64.f + EPS); const float* gn = hh < 8 ? qn : kn;
        const float fr = powf(10000.f, -(float)i / 16.f);
        const float ar = (float)(pos / GRIDW) * fr, ac = (float)(pos % GRIDW) * fr;
        const float cr = cosf(ar), sr = sinf(ar), cc = cosf(ac), sc = sinf(ac);
        const float x1 = zh[i] * rn * gn[i], x2 = zh[16 + i] * rn * gn[16 + i], x3 = zh[32 + i] * rn * gn[32 + i], x4 = zh[48 + i] * rn * gn[48 + i];
        float o0 = x1 * cr - x2 * sr, o1 = x2 * cr + x1 * sr, o2 = x3 * cc - x4 * sc, o3 = x4 * cc + x3 * sc;
        if (hh < 8) { o0 *= C2; o1 *= C2; o2 *= C2; o3 *= C2; bf16_t* o = Q + (size_t)t * DATT + hh * 64; o[i] = f2bf(o0); o[16 + i] = f2bf(o1); o[32 + i] = f2bf(o2); o[48 + i] = f2bf(o3); }
        else { bf16_t* o = K + (size_t)t * DKV + (hh - 8) * 64; o[i] = f2bf(o0); o[16 + i] = f2bf(o1); o[32 + i] = f2bf(o2); o[48 + i] = f2bf(o3); }
    }
    for (int it = tid; it < 4 * DKV; it += 256) { const int r = it / DKV, c = it % DKV; V[(size_t)(t0 + r) * DKV + c] = f2bf(zs[r][DATT + DKV + c]); }
    for (int it = tid; it < 4 * DLRU; it += 256) { const int r = it / DLRU, c = it % DLRU;
        XR[(size_t)(t0 + r) * DLRU + c] = f2bf(zs[r][DATT + 2 * DKV + c]);
        XG[(size_t)(t0 + r) * DLRU + c] = f2bf(gelu_tanh(zs[r][DATT + 2 * DKV + DLRU + c])); }
}

__global__ void __launch_bounds__(128) attn(const bf16_t* __restrict__ Q, const bf16_t* __restrict__ K, const bf16_t* __restrict__ V, bf16_t* Y) {
    __shared__ float Ks[64][64]; __shared__ float Vs[64][64];
    const int tid = threadIdx.x, h = blockIdx.y, b = blockIdx.z, kvh = h / 4;
    const size_t trow = (size_t)b * SEQ + blockIdx.x * 128 + tid;
    float q[64], o[64];
#pragma unroll
    for (int d = 0; d < 64; ++d) { q[d] = bf2f(Q[trow * DATT + h * 64 + d]); o[d] = 0.f; }
    float m = -1e30f, l = 0.f;
    for (int kt = 0; kt < SEQ / 64; ++kt) {
        __syncthreads();
        for (int i = tid; i < 64 * 64; i += 128) { const int r = i >> 6, c = i & 63; const size_t kr = (size_t)b * SEQ + kt * 64 + r;
            Ks[r][c] = bf2f(K[kr * DKV + kvh * 64 + c]); Vs[r][c] = bf2f(V[kr * DKV + kvh * 64 + c]); }
        __syncthreads();
        for (int j = 0; j < 64; ++j) {
            float s = 0.f;
#pragma unroll
            for (int d = 0; d < 64; ++d) s += q[d] * Ks[j][d];
            if (s > m) { const float f = exp2f(m - s); l *= f;
#pragma unroll
                for (int d = 0; d < 64; ++d) o[d] *= f; m = s; }
            const float p = exp2f(s - m); l += p;
#pragma unroll
            for (int d = 0; d < 64; ++d) o[d] += p * Vs[j][d];
        }
    }
    const float il = 1.f / l;
#pragma unroll
    for (int d = 0; d < 64; ++d) Y[trow * DM + h * 64 + d] = f2bf(o[d] * il);
}

__global__ void __launch_bounds__(128) lru(const bf16_t* __restrict__ XR, const float* __restrict__ cw, const float* __restrict__ cb, const float* __restrict__ wa, const float* __restrict__ ba,
                                           const float* __restrict__ wx, const float* __restrict__ bx, const float* __restrict__ lam, float* HF, float* HB) {
    __shared__ float xcs[2][64];
    const int tid = threadIdx.x, j = tid & 63, e = tid >> 6, b = blockIdx.x / NBLK, n = blockIdx.x % NBLK, c = n * 64 + j;
    float wav[64], wxv[64];
#pragma unroll
    for (int k = 0; k < 64; ++k) { wav[k] = wa[(((size_t)e * NBLK + n) * 64 + k) * 64 + j]; wxv[k] = wx[(((size_t)e * NBLK + n) * 64 + k) * 64 + j]; }
    const float bav = ba[e * DLRU + c], bxv = bx[e * DLRU + c];
    const float lm = lam[e * DLRU + c]; const float lsg = -log1pf(expf(-lm));
    const float w0 = cw[0 * DLRU + c], w1 = cw[1 * DLRU + c], w2 = cw[2 * DLRU + c], w3 = cw[3 * DLRU + c], cbv = cb[c];
    float* H = e == 0 ? HF : HB; float h = 0.f;
    for (int s = 0; s < SEQ; ++s) {
        const int t = e == 0 ? s : SEQ - 1 - s; const size_t base = (size_t)b * SEQ;
        float xc = cbv;
        if (t - 2 >= 0) xc += w0 * bf2f(XR[(base + t - 2) * DLRU + c]);
        if (t - 1 >= 0) xc += w1 * bf2f(XR[(base + t - 1) * DLRU + c]);
        xc += w2 * bf2f(XR[(base + t) * DLRU + c]);
        if (t + 1 < SEQ) xc += w3 * bf2f(XR[(base + t + 1) * DLRU + c]);
        __syncthreads();
        xcs[e][j] = xc;
        __syncthreads();
        float ga = bav, gx = bxv;
#pragma unroll
        for (int k = 0; k < 64; ++k) { const float v = xcs[e][k]; ga += v * wav[k]; gx += v * wxv[k]; }
        const float r = sigmoidf(ga), ig = sigmoidf(gx), la = 8.f * r * lsg, a = expf(la), u = sqrtf(-expm1f(2.f * la)) * (ig * xc);
        h = a * h + u;
        H[(base + t) * DLRU + c] = h;
    }
}

__global__ void __launch_bounds__(256) merge(bf16_t* Y, const float* __restrict__ HF, const float* __restrict__ HB, const bf16_t* __restrict__ XG, const float* __restrict__ ga, const float* __restrict__ gl) {
    __shared__ float red[4];
    const int tid = threadIdx.x; const size_t t = blockIdx.x;
    float a0 = bf2f(Y[t * DM + tid]), a1 = bf2f(Y[t * DM + 256 + tid]);
    float s = block_sum(a0 * a0 + a1 * a1, red); float rn = rsqrtf(s / DATT + EPS);
    Y[t * DM + tid] = f2bf(a0 * rn * ga[tid]); Y[t * DM + 256 + tid] = f2bf(a1 * rn * ga[256 + tid]);
    float l0 = (HF[t * DLRU + tid] + HB[t * DLRU + tid]) * bf2f(XG[t * DLRU + tid]);
    float l1 = (HF[t * DLRU + 256 + tid] + HB[t * DLRU + 256 + tid]) * bf2f(XG[t * DLRU + 256 + tid]);
    s = block_sum(l0 * l0 + l1 * l1, red); rn = rsqrtf(s / DLRU + EPS);
    Y[t * DM + DATT + tid] = f2bf(l0 * rn * gl[tid]); Y[t * DM + DATT + 256 + tid] = f2bf(l1 * rn * gl[256 + tid]);
}

__global__ void __launch_bounds__(256) s4(const float* __restrict__ x, const bf16_t* __restrict__ Y, const float* __restrict__ w_out, float* H) {
    __shared__ float As[DM * 4];
    const int tid = threadIdx.x, t0 = blockIdx.x * 4;
    for (int i = tid; i < DM * 4; i += 256) { const int k = i >> 2, r = i & 3; As[i] = bf2f(Y[(size_t)(t0 + r) * DM + k]); }
    __syncthreads();
    for (int j = 0; j < DM / 256; ++j) { const int col = tid + 256 * j; float acc[4] = {0.f, 0.f, 0.f, 0.f}; dot4(As, DM, w_out, DM, col, acc);
        for (int r = 0; r < 4; ++r) H[(size_t)(t0 + r) * DM + col] = x[(size_t)(t0 + r) * DM + col] + acc[r]; }
}
__global__ void __launch_bounds__(256) s5(const float* __restrict__ H, const float* __restrict__ g, const float* __restrict__ w_up, bf16_t* M) {
    __shared__ float As[DM * 4]; __shared__ float red[4]; __shared__ float rs[4];
    const int tid = threadIdx.x, t0 = blockIdx.x * 4;
    for (int r = 0; r < 4; ++r) { float s = 0.f; for (int i = tid; i < DM; i += 256) { const float v = H[(size_t)(t0 + r) * DM + i]; s += v * v; }
        s = block_sum(s, red); if (tid == 0) rs[r] = rsqrtf(s / DM + EPS); }
    __syncthreads();
    for (int i = tid; i < DM * 4; i += 256) { const int k = i >> 2, r = i & 3; As[i] = H[(size_t)(t0 + r) * DM + k] * rs[r] * g[k]; }
    __syncthreads();
    for (int j = 0; j < DFF / 256; ++j) { const int col = tid + 256 * j; float acc[4] = {0.f, 0.f, 0.f, 0.f}; dot4(As, DM, w_up, DFF, col, acc);
        for (int r = 0; r < 4; ++r) { const float v = fmaxf(acc[r], 0.f); M[(size_t)(t0 + r) * DFF + col] = f2bf(v * v); } }
}
__global__ void __launch_bounds__(256) s6(float* H, const bf16_t* __restrict__ M, const float* __restrict__ w_down) {
    __shared__ float As[2048 * 4];
    const int tid = threadIdx.x, t0 = blockIdx.x * 4;
    float acc[4][4];
#pragma unroll
    for (int j = 0; j < 4; ++j) for (int r = 0; r < 4; ++r) acc[j][r] = 0.f;
    for (int kh = 0; kh < 2; ++kh) {
        __syncthreads();
        for (int i = tid; i < 2048 * 4; i += 256) { const int k = i >> 2, r = i & 3; As[i] = bf2f(M[(size_t)(t0 + r) * DFF + kh * 2048 + k]); }
        __syncthreads();
#pragma unroll
        for (int j = 0; j < 4; ++j) dot4(As, 2048, w_down + (size_t)kh * 2048 * DM, DM, tid + 256 * j, acc[j]);
    }
#pragma unroll
    for (int j = 0; j < 4; ++j) for (int r = 0; r < 4; ++r) H[(size_t)(t0 + r) * DM + tid + 256 * j] += acc[j][r];
}
__global__ void __launch_bounds__(256) s7(float* H, const float* __restrict__ p, const float* __restrict__ g, const float* __restrict__ w_gate, const float* __restrict__ w_proj, const float* __restrict__ gf) {
    __shared__ float As[DM * 4]; __shared__ float Ps[DPLE * 4]; __shared__ float red[4]; __shared__ float rs[4];
    const int tid = threadIdx.x, t0 = blockIdx.x * 4;
    for (int r = 0; r < 4; ++r) { float s = 0.f; for (int i = tid; i < DM; i += 256) { const float v = H[(size_t)(t0 + r) * DM + i]; s += v * v; }
        s = block_sum(s, red); if (tid == 0) rs[r] = rsqrtf(s / DM + EPS); }
    __syncthreads();
    for (int i = tid; i < DM * 4; i += 256) { const int k = i >> 2, r = i & 3; As[i] = H[(size_t)(t0 + r) * DM + k] * rs[r] * g[k]; }
    for (int i = tid; i < DPLE * 4; i += 256) { const int k = i >> 2, r = i & 3; Ps[i] = p[(size_t)(t0 + r) * DPLE + k]; }
    __syncthreads();
    float h3[4][4];
#pragma unroll
    for (int j = 0; j < 4; ++j) { const int col = tid + 256 * j; float ag[4] = {0.f, 0.f, 0.f, 0.f}, ap[4] = {0.f, 0.f, 0.f, 0.f};
        dot4(As, DM, w_gate, DM, col, ag); dot4(Ps, DPLE, w_proj, DM, col, ap);
        for (int r = 0; r < 4; ++r) h3[j][r] = H[(size_t)(t0 + r) * DM + col] + sigmoidf(ag[r]) * ap[r]; }
#pragma unroll
    for (int r = 0; r < 4; ++r) { float s = 0.f; for (int j = 0; j < 4; ++j) s += h3[j][r] * h3[j][r];
        s = block_sum(s, red); const float rn = rsqrtf(s / DM + EPS);
        for (int j = 0; j < 4; ++j) { const int col = tid + 256 * j; H[(size_t)(t0 + r) * DM + col] = h3[j][r] * rn * gf[col]; } }
}
}

namespace pg8 {
#define PG8_LAS __attribute__((address_space(3)))
typedef unsigned short bf16_t;
typedef short bf16x8 __attribute__((ext_vector_type(8)));
typedef float f32x4 __attribute__((ext_vector_type(4)));
typedef unsigned u32x4 __attribute__((ext_vector_type(4)));
constexpr int BM = 256, BK = 64, HALF = 128, HTB = HALF * BK * 2  , STAGE_BYTES = 8 * HTB, NXCD = 8, WGM = 8;

__host__ __device__ __forceinline__ int lds_byte(int r, int c) { const int st = (r >> 4) * 2 + (c >> 5), rr = r & 15, cc = c & 31, ob = rr * 64 + cc * 2; return st * 1024 + (ob ^ (((ob >> 9) & 1) << 5)); }
__host__ __device__ __forceinline__ void stage_rc(int b, int& R, int& C) { const int st = b / 1024, sb = b % 1024, swz = sb ^ (((sb >> 9) & 1) << 5); R = (st >> 1) * 16 + swz / 64; C = (st & 1) * 32 + (swz % 64) / 2; }
__host__ __device__ __forceinline__ int perm32(int rho) { const int n = rho >> 4, i = rho & 15; return 8 * (i >> 2) + 4 * n + (i & 3); }

struct Unit { int pm, pn; };
struct Gemm { const bf16_t* A; const bf16_t* Bt; int M, N, K; };

struct StaticOrder {
    int nM, nN, nwg, G, c;
    __host__ __device__ void init(int M, int N, int G_, int c_) { nM = M / BM; nN = N / BM; nwg = nM * nN; G = G_; c = c_; }
    __host__ __device__ bool next(int i, Unit& u) const {
        const long L = (long)i * G + c; if (L >= nwg) return false;
        int wgid = (int)L; { const int q = nwg / NXCD, r = nwg % NXCD, xcd = wgid % NXCD, off = wgid / NXCD; wgid = (xcd < r ? xcd * (q + 1) : r * (q + 1) + (xcd - r) * q) + off; }
        const int nig = WGM * nN, gid = wgid / nig, fm = gid * WGM, gsz = (nM - fm) < WGM ? (nM - fm) : WGM;
        u.pm = fm + ((wgid % nig) % gsz); u.pn = (wgid % nig) / gsz; return true;
    }
    __device__ __forceinline__ void a_ready(const Unit&) const {}
    __device__ __forceinline__ void done(const Unit&) const {}
};

__device__ __forceinline__ unsigned cvt_pk_bf16(float lo, float hi) { unsigned r; asm volatile("v_cvt_pk_bf16_f32 %0, %1, %2" : "=v"(r) : "v"(lo), "v"(hi)); return r; }
typedef float f32x2 __attribute__((ext_vector_type(2)));
__device__ __forceinline__ f32x2 gelu_pk(f32x2 v) {
    const f32x2 av = __builtin_elementwise_abs(v), d = av * 0.2316418882f + 1.0f;
    f32x2 t; t.x = __builtin_amdgcn_rcpf(d.x); t.y = __builtin_amdgcn_rcpf(d.y);
    f32x2 q = t * 0.5307027145f + (-0.7265760135f); q = q * t + 0.7107068705f; q = q * t + (-0.142248368f); q = q * t + 0.127414796f; q = q * t;
    const f32x2 s = (v * v) * (-0.72134752044f);
    f32x2 e; e.x = __builtin_amdgcn_exp2f(s.x); e.y = __builtin_amdgcn_exp2f(s.y);
    const f32x2 m = v * (q * e), r = v - m;
    f32x2 o; o.x = v.x < 0.f ? m.x : r.x; o.y = v.y < 0.f ? m.y : r.y; return o;
}

template <int ACT  > struct EpiBf16 {
    static constexpr bool PERM = true, AFTER_DRAIN = false; static_assert(ACT == 0 || ACT == 1, "EpiBf16: ACT is 0 (none) or 1 (gelu_pk)");
    bf16_t* O; int ldc; const float* bias; int split_cols; size_t split_stride; float scale0;
    __device__ __forceinline__ void operator()(const f32x4 (&acc)[2][2][4][2], const Unit& u, int wr, int wc, int fr, int fq) const {
        const int row0 = u.pm * BM + wr * 64 + fr; int colt = u.pn * BM; bf16_t* base = O;
        float sc = 1.f; if (split_cols) { const int t = colt / split_cols; base += (size_t)t * split_stride; colt -= t * split_cols; if (t == 0) sc = scale0; }
        const int col0 = colt + wc * 32 + 8 * fq, bcol0 = u.pn * BM + wc * 32 + 8 * fq;
        f32x4 bv[2][2];
#pragma unroll
        for (int bj = 0; bj < 2; ++bj)
#pragma unroll
            for (int n = 0; n < 2; ++n) bv[bj][n] = bias ? *(const f32x4*)(bias + bcol0 + bj * HALF + 4 * n) : (f32x4){0.f, 0.f, 0.f, 0.f};
#pragma unroll
        for (int ai = 0; ai < 2; ++ai)
#pragma unroll
            for (int m = 0; m < 4; ++m) { bf16_t* rowp = base + (size_t)(row0 + ai * HALF + m * 16) * ldc + col0;
#pragma unroll
                for (int bj = 0; bj < 2; ++bj) { f32x4 v0 = acc[ai][bj][m][0] + bv[bj][0], v1 = acc[ai][bj][m][1] + bv[bj][1];
                    if (ACT == 1) { f32x2 a = gelu_pk((f32x2){v0[0], v0[1]}), b = gelu_pk((f32x2){v0[2], v0[3]}), c = gelu_pk((f32x2){v1[0], v1[1]}), d = gelu_pk((f32x2){v1[2], v1[3]});
                        v0 = (f32x4){a.x, a.y, b.x, b.y}; v1 = (f32x4){c.x, c.y, d.x, d.y}; }
                    v0 = v0 * sc; v1 = v1 * sc; u32x4 w; w.x = cvt_pk_bf16(v0[0], v0[1]); w.y = cvt_pk_bf16(v0[2], v0[3]); w.z = cvt_pk_bf16(v1[0], v1[1]); w.w = cvt_pk_bf16(v1[2], v1[3]);
                    *(u32x4*)(rowp + bj * HALF) = w; } }
    }
};
typedef unsigned u32x2 __attribute__((ext_vector_type(2)));
__device__ __forceinline__ float wsum4(float s) { s += __shfl_xor(s, 16); s += __shfl_xor(s, 32); return s; }
__device__ __forceinline__ float dot4f(const f32x4 a) { return (a[0] * a[0] + a[1] * a[1]) + (a[2] * a[2] + a[3] * a[3]); }
__device__ __forceinline__ u32x2 pack4(const f32x4 v) { u32x2 w; w.x = cvt_pk_bf16(v[0], v[1]); w.y = cvt_pk_bf16(v[2], v[3]); return w; }
__device__ __forceinline__ f32x4 unpack4(const u32x2 w) { f32x4 v; v[0] = __uint_as_float(w.x << 16); v[1] = __uint_as_float(w.x & 0xffff0000u); v[2] = __uint_as_float(w.y << 16); v[3] = __uint_as_float(w.y & 0xffff0000u); return v; }
__device__ __forceinline__ float gelu_tanh_fast(float x) {
    const float e = __builtin_amdgcn_exp2f(-2.302208198f * (x + 0.044715f * x * x * x)); return x * __builtin_amdgcn_rcpf(1.0f + e);
}
__device__ __forceinline__ float sigmoid_fast(float x) { return __builtin_amdgcn_rcpf(1.0f + __builtin_amdgcn_exp2f(-1.4426950408889634f * x)); }
__device__ __forceinline__ float rstd16(const float* ss) {
    const f32x4 a = *(const f32x4*)(ss), b = *(const f32x4*)(ss + 4), c = *(const f32x4*)(ss + 8), d = *(const f32x4*)(ss + 12);
    const float s = ((a[0] + a[1]) + (a[2] + a[3])) + ((b[0] + b[1]) + (b[2] + b[3])) + ((c[0] + c[1]) + (c[2] + c[3])) + ((d[0] + d[1]) + (d[2] + d[3]));
    return rsqrtf(s * (1.0f / 1024.0f) + EPS);
}

struct EpiIn {
    static constexpr bool PERM = false, AFTER_DRAIN = false;
    const float* rsx; const float* qn; const float* kn; const float* rope;
    bf16_t *Q, *K, *V, *XR, *XG;
    __device__ __forceinline__ void operator()(const f32x4 (&acc)[2][2][4][2], const Unit& u, int wr, int wc, int fr, int fq) const {
        const int rowb = u.pm * BM + wr * 64 + fr;
        if (u.pn < 2 || (u.pn == 2 && wc < 2)) {
            const bool isq = u.pn < 2;
            const float* gn = isq ? qn : kn; const float osc = isq ? C2 : 1.0f;
            f32x4 g[2][2];
#pragma unroll
            for (int bj = 0; bj < 2; ++bj)
#pragma unroll
                for (int n = 0; n < 2; ++n) g[bj][n] = *(const f32x4*)(gn + 32 * bj + 16 * n + 4 * fq) * osc;
#pragma unroll
            for (int ai = 0; ai < 2; ++ai) {
                const int ridx = (4 * u.pm + 2 * ai + wr) & 63;
                const f32x4 cr = *(const f32x4*)(rope + ridx * 16 + 4 * fq), sr = *(const f32x4*)(rope + 1024 + ridx * 16 + 4 * fq);
#pragma unroll
                for (int m = 0; m < 4; ++m) {
                    const int t = rowb + ai * HALF + m * 16; const float rs = rsx[t]; const int cidx = 16 * m + fr;
                    const f32x4 cc = *(const f32x4*)(rope + cidx * 16 + 4 * fq), sc = *(const f32x4*)(rope + 1024 + cidx * 16 + 4 * fq);
                    f32x4 v00 = acc[ai][0][m][0] * rs, v01 = acc[ai][0][m][1] * rs, v10 = acc[ai][1][m][0] * rs, v11 = acc[ai][1][m][1] * rs;
                    const float ss = wsum4((dot4f(v00) + dot4f(v01)) + (dot4f(v10) + dot4f(v11)));
                    const float rn = rsqrtf(ss * (1.0f / 64.0f) + EPS);
                    v00 = v00 * rn * g[0][0]; v01 = v01 * rn * g[0][1]; v10 = v10 * rn * g[1][0]; v11 = v11 * rn * g[1][1];
                    const f32x4 o0 = v00 * cr - v01 * sr, o1 = v01 * cr + v00 * sr, o2 = v10 * cc - v11 * sc, o3 = v11 * cc + v10 * sc;
                    bf16_t* dst = isq ? Q + (size_t)t * 512 + (u.pn * 4 + wc) * 64 + 4 * fq : K + (size_t)t * 128 + wc * 64 + 4 * fq;
                    *(u32x2*)(dst) = pack4(o0); *(u32x2*)(dst + 16) = pack4(o1); *(u32x2*)(dst + 32) = pack4(o2); *(u32x2*)(dst + 48) = pack4(o3);
                    asm volatile("" ::: "memory");
                }
            }
        } else if (u.pn == 2) {
#pragma unroll
            for (int ai = 0; ai < 2; ++ai)
#pragma unroll
                for (int m = 0; m < 4; ++m) {
                    const int t = rowb + ai * HALF + m * 16; const float rs = rsx[t];
                    bf16_t* dst = V + (size_t)t * 128 + (wc - 2) * 64 + 4 * fq;
#pragma unroll
                    for (int bj = 0; bj < 2; ++bj)
#pragma unroll
                        for (int n = 0; n < 2; ++n) *(u32x2*)(dst + 32 * bj + 16 * n) = pack4(acc[ai][bj][m][n] * rs);
                }
        } else {
            const bool isg = u.pn >= 5;
            bf16_t* base = (isg ? XG + (u.pn - 5) * 256 : XR + (u.pn - 3) * 256) + wc * 32 + 8 * fq;
#pragma unroll
            for (int ai = 0; ai < 2; ++ai)
#pragma unroll
                for (int m = 0; m < 4; ++m) {
                    const int t = rowb + ai * HALF + m * 16; const float rs = rsx[t];
#pragma unroll
                    for (int bj = 0; bj < 2; ++bj) {
                        f32x4 v0 = acc[ai][bj][m][0] * rs, v1 = acc[ai][bj][m][1] * rs;
                        if (isg) {
#pragma unroll
                            for (int e = 0; e < 4; ++e) { v0[e] = gelu_tanh_fast(v0[e]); v1[e] = gelu_tanh_fast(v1[e]); }
                        }
                        u32x4 w; w.x = cvt_pk_bf16(v0[0], v0[1]); w.y = cvt_pk_bf16(v0[2], v0[3]); w.z = cvt_pk_bf16(v1[0], v1[1]); w.w = cvt_pk_bf16(v1[2], v1[3]);
                        *(u32x4*)(base + (size_t)t * 512 + bj * HALF) = w;
                    }
                }
        }
    }
};

template <bool STORE_OUT> struct EpiRes {
    static constexpr bool PERM = false, AFTER_DRAIN = false;
    bf16_t* hb; float* ss;
    __device__ __forceinline__ void operator()(const f32x4 (&acc)[2][2][4][2], const Unit& u, int wr, int wc, int fr, int fq) const {
        const int rowb = u.pm * BM + wr * 64 + fr, col0 = u.pn * BM + wc * 32 + 4 * fq;
#pragma unroll
        for (int ai = 0; ai < 2; ++ai)
#pragma unroll
            for (int m = 0; m < 4; ++m) {
                const int t = rowb + ai * HALF + m * 16; const size_t off = (size_t)t * 1024 + col0; float s = 0.f;
                u32x2 bv[2][2];
#pragma unroll
                for (int bj = 0; bj < 2; ++bj)
#pragma unroll
                    for (int n = 0; n < 2; ++n) bv[bj][n] = *(const u32x2*)(hb + off + bj * HALF + n * 16);
#pragma unroll
                for (int bj = 0; bj < 2; ++bj)
#pragma unroll
                    for (int n = 0; n < 2; ++n) {
                        const f32x4 o = unpack4(bv[bj][n]) + acc[ai][bj][m][n];
                        if (STORE_OUT) *(u32x2*)(hb + off + bj * HALF + n * 16) = pack4(o); s += dot4f(o);
                    }
                s = wsum4(s); if (fq == 0) ss[(size_t)t * 16 + u.pn * 4 + wc] = s;
            }
    }
};

struct EpiUp {
    static constexpr bool PERM = true, AFTER_DRAIN = false;
    const float* ss; bf16_t* M;
    __device__ __forceinline__ void operator()(const f32x4 (&acc)[2][2][4][2], const Unit& u, int wr, int wc, int fr, int fq) const {
        const int rowb = u.pm * BM + wr * 64 + fr, col0 = u.pn * BM + wc * 32 + 8 * fq;
#pragma unroll
        for (int ai = 0; ai < 2; ++ai)
#pragma unroll
            for (int m = 0; m < 4; ++m) {
                const int t = rowb + ai * HALF + m * 16; const float rs = rstd16(ss + (size_t)t * 16);
#pragma unroll
                for (int bj = 0; bj < 2; ++bj) {
                    f32x4 v0 = acc[ai][bj][m][0] * rs, v1 = acc[ai][bj][m][1] * rs;
#pragma unroll
                    for (int e = 0; e < 4; ++e) { const float a = fmaxf(v0[e], 0.f), b = fmaxf(v1[e], 0.f); v0[e] = a * a; v1[e] = b * b; }
                    u32x4 w; w.x = cvt_pk_bf16(v0[0], v0[1]); w.y = cvt_pk_bf16(v0[2], v0[3]); w.z = cvt_pk_bf16(v1[0], v1[1]); w.w = cvt_pk_bf16(v1[2], v1[3]);
                    *(u32x4*)(M + (size_t)t * 4096 + col0 + bj * HALF) = w;
                }
            }
    }
};

template <bool STORE_OUT> struct EpiGate {
    static constexpr bool PERM = false, AFTER_DRAIN = false;
    const float* ss2; const bf16_t* pp; const bf16_t* hb; bf16_t* h3b; float* ss3;
    __device__ __forceinline__ void operator()(const f32x4 (&acc)[2][2][4][2], const Unit& u, int wr, int wc, int fr, int fq) const {
        const int rowb = u.pm * BM + wr * 64 + fr, col0 = u.pn * BM + wc * 32 + 4 * fq;
#pragma unroll
        for (int ai = 0; ai < 2; ++ai)
#pragma unroll
            for (int m = 0; m < 4; ++m) {
                const int t = rowb + ai * HALF + m * 16; const float rs = rstd16(ss2 + (size_t)t * 16); const size_t off = (size_t)t * 1024 + col0; float s = 0.f;
#pragma unroll
                for (int bj = 0; bj < 2; ++bj)
#pragma unroll
                    for (int n = 0; n < 2; ++n) {
                        const f32x4 pv = unpack4(*(const u32x2*)(pp + off + bj * HALF + n * 16)); const f32x4 a = acc[ai][bj][m][n] * rs; f32x4 o = unpack4(*(const u32x2*)(hb + off + bj * HALF + n * 16));
#pragma unroll
                        for (int e = 0; e < 4; ++e) o[e] += sigmoid_fast(a[e]) * pv[e];
                        if (STORE_OUT) *(u32x2*)(h3b + off + bj * HALF + n * 16) = pack4(o); s += dot4f(o);
                    }
                s = wsum4(s); if (fq == 0) ss3[(size_t)t * 16 + u.pn * 4 + wc] = s;
            }
    }
};

struct PpOrder {
    int c;
    __device__ __forceinline__ bool next(int i, Unit& u) const { if (c < 192 || i >= 4) return false; const int idx = (c - 192) * 4 + i; u.pm = idx >> 2; u.pn = idx & 3; return true; }
    __device__ __forceinline__ void a_ready(const Unit&) const {}
    __device__ __forceinline__ void done(const Unit&) const {}
};
template <class Epi, class Sched, bool ALIGN_EPI = false, bool SP2 = false>
__device__ __forceinline__ void gemm_phase(PG8_LAS unsigned char* lds, const Gemm g, const Sched& S, const Epi& E) {
    const int tid = threadIdx.x, wid = __builtin_amdgcn_readfirstlane(tid >> 6), lane = tid & 63, wr = wid >> 2, wc = wid & 3, fr = lane & 15, fq = lane >> 4;
    const int K = g.K, nt = K / BK;
    unsigned voffA[2], voffB[2];
#pragma unroll
    for (int i = 0; i < 2; ++i) { int R, C; stage_rc(tid * 16 + i * 8192, R, C); const int Rb = Epi::PERM ? ((R & ~31) + perm32(R & 31)) : R;
        voffA[i] = (unsigned)(R * K + C) * 2u; voffB[i] = (unsigned)(Rb * K + C) * 2u; }
    const size_t kstep = (size_t)(BK * 2);
    const size_t hstep = (size_t)HALF * K * 2;
    const size_t tstep = 2 * hstep;
    const unsigned ldsw = (unsigned)wid * 1024u;
    const int aoff = lds_byte(wr * 64 + fr, fq * 8), boff = lds_byte(wc * 32 + fr, fq * 8);
#define PG8_SA(b, h) (((b) * 2 + (h)) * HTB)
#define PG8_SB(b, h) ((4 + (b) * 2 + (h)) * HTB)
#define PG8_STAGE(bufoff, gbase, voff) do { _Pragma("unroll") for (int _i = 0; _i < 2; ++_i) \
        __builtin_amdgcn_global_load_lds((const unsigned*)((const char*)(gbase) + (voff)[_i]), (PG8_LAS unsigned*)(lds + (bufoff) + ldsw + _i * 8192), 16, 0, 0); } while (0)
#define PG8_LDA(dst, b, h) do { _Pragma("unroll") for (int m = 0; m < 4; ++m) _Pragma("unroll") for (int k = 0; k < 2; ++k) dst[m][k] = *(const PG8_LAS bf16x8*)(lds + PG8_SA(b, h) + aoff + m * 2048 + k * 1024); } while (0)
#define PG8_LDB(dst, b, h) do { _Pragma("unroll") for (int n = 0; n < 2; ++n) _Pragma("unroll") for (int k = 0; k < 2; ++k) dst[n][k] = *(const PG8_LAS bf16x8*)(lds + PG8_SB(b, h) + boff + n * 2048 + k * 1024); } while (0)
#define PG8_MMA(ai, bj, At, Bt) do { __builtin_amdgcn_s_setprio(1); _Pragma("unroll") for (int m = 0; m < 4; ++m) _Pragma("unroll") for (int n = 0; n < 2; ++n) _Pragma("unroll") for (int k = 0; k < 2; ++k) \
        acc[ai][bj][m][n] = __builtin_amdgcn_mfma_f32_16x16x32_bf16(Bt[n][k], At[m][k], acc[ai][bj][m][n], 0, 0, 0); __builtin_amdgcn_s_setprio(0); } while (0)
#define PG8_WAIT_V(n) asm volatile("s_waitcnt vmcnt(" #n ")" ::: "memory")
#define PG8_WAIT_L(n) asm volatile("s_waitcnt lgkmcnt(" #n ")" ::: "memory")
#define PG8_BAR __builtin_amdgcn_s_barrier()
#define PG8_SCHED __builtin_amdgcn_sched_barrier(0)
    Unit cur, nxt; int ui = 0;
    if (!S.next(0, cur)) return;
    f32x4 acc[2][2][4][2];
#pragma unroll
    for (int a = 0; a < 2; ++a)
#pragma unroll
        for (int b = 0; b < 2; ++b)
#pragma unroll
            for (int m = 0; m < 4; ++m)
#pragma unroll
                for (int n = 0; n < 2; ++n) acc[a][b][m][n] = (f32x4){0.f, 0.f, 0.f, 0.f};
    bf16x8 At[4][2], B0[2][2], B1[2][2];
    const char* cA = (const char*)g.A + (size_t)cur.pm * tstep; const char* cB = (const char*)g.Bt + (size_t)cur.pn * tstep;
    S.a_ready(cur);
    if constexpr (SP2) {
        PG8_STAGE(PG8_SB(0, 0), cB, voffB); PG8_STAGE(PG8_SB(0, 1), cB + hstep, voffB); PG8_STAGE(PG8_SA(0, 0), cA, voffA); PG8_STAGE(PG8_SA(0, 1), cA + hstep, voffA);
        if (wr == 1) PG8_BAR;
        PG8_WAIT_V(2); PG8_BAR;
        PG8_STAGE(PG8_SB(1, 0), cB + kstep, voffB); PG8_STAGE(PG8_SA(1, 0), cA + kstep, voffA); PG8_STAGE(PG8_SB(1, 1), cB + hstep + kstep, voffB);
        PG8_WAIT_V(6); PG8_BAR;
    } else {
        PG8_STAGE(PG8_SB(0, 0), cB, voffB); PG8_STAGE(PG8_SA(0, 0), cA, voffA); PG8_STAGE(PG8_SB(0, 1), cB + hstep, voffB); PG8_STAGE(PG8_SA(0, 1), cA + hstep, voffA);
        if (wr == 1) PG8_BAR;
        PG8_WAIT_V(4); PG8_BAR;
        PG8_STAGE(PG8_SB(1, 0), cB + kstep, voffB); PG8_STAGE(PG8_SA(1, 0), cA + kstep, voffA); PG8_STAGE(PG8_SB(1, 1), cB + hstep + kstep, voffB);
        PG8_WAIT_V(6); PG8_BAR;
    }
    for (;;) {
        const bool has_next = S.next(ui + 1, nxt);
        const char* nA = has_next ? (const char*)g.A + (size_t)nxt.pm * tstep : cA; const char* nB = has_next ? (const char*)g.Bt + (size_t)nxt.pn * tstep : cB;
        for (int t = 0; t < nt; t += 2) {
            const bool last = (t == nt - 2);
            const char* a1 = cA + (size_t)(t + 1) * kstep;
            const char* a2 = last ? nA : cA + (size_t)(t + 2) * kstep; const char* b2 = last ? nB : cB + (size_t)(t + 2) * kstep;
            const char* a3 = a2 + kstep; const char* b3 = b2 + kstep;
            if (last && has_next) S.a_ready(nxt);
            if constexpr (SP2) {
            PG8_LDB(B0, 0, 0); PG8_LDB(B1, 0, 1); PG8_SCHED; PG8_LDA(At, 0, 0); PG8_STAGE(PG8_SA(1, 1), a1 + hstep, voffA);
            PG8_WAIT_V(8); PG8_WAIT_L(0); PG8_BAR; PG8_MMA(0, 0, At, B0); PG8_MMA(0, 1, At, B1); PG8_BAR; PG8_SCHED;
            PG8_LDA(At, 0, 1); PG8_STAGE(PG8_SB(0, 0), b2, voffB); PG8_STAGE(PG8_SB(0, 1), b2 + hstep, voffB); PG8_STAGE(PG8_SA(0, 0), a2, voffA);
            PG8_WAIT_V(8); PG8_WAIT_L(0); PG8_BAR; PG8_MMA(1, 0, At, B0); PG8_MMA(1, 1, At, B1); PG8_BAR; PG8_SCHED;
            PG8_LDB(B0, 1, 0); PG8_LDB(B1, 1, 1); PG8_SCHED; PG8_LDA(At, 1, 0); PG8_STAGE(PG8_SA(0, 1), a2 + hstep, voffA);
            PG8_WAIT_V(8); PG8_WAIT_L(0); PG8_BAR; PG8_MMA(0, 0, At, B0); PG8_MMA(0, 1, At, B1); PG8_BAR; PG8_SCHED;
            PG8_LDA(At, 1, 1); PG8_STAGE(PG8_SB(1, 0), b3, voffB); PG8_STAGE(PG8_SB(1, 1), b3 + hstep, voffB); PG8_STAGE(PG8_SA(1, 0), a3, voffA);
            PG8_WAIT_V(8); PG8_WAIT_L(0); PG8_BAR; PG8_MMA(1, 0, At, B0); PG8_MMA(1, 1, At, B1); PG8_BAR; PG8_SCHED;
            } else {
            PG8_LDB(B0, 0, 0); PG8_SCHED; PG8_LDA(At, 0, 0); PG8_STAGE(PG8_SA(1, 1), a1 + hstep, voffA);
            PG8_WAIT_L(8); PG8_BAR; PG8_WAIT_L(0); PG8_MMA(0, 0, At, B0); PG8_BAR; PG8_SCHED;
            PG8_LDB(B1, 0, 1); PG8_STAGE(PG8_SB(0, 0), b2, voffB);
            PG8_BAR; PG8_WAIT_L(0); PG8_MMA(0, 1, At, B1); PG8_BAR;
            PG8_LDA(At, 0, 1); PG8_STAGE(PG8_SA(0, 0), a2, voffA);
            PG8_BAR; PG8_WAIT_L(0); PG8_MMA(1, 0, At, B0); PG8_BAR; PG8_SCHED;
            PG8_STAGE(PG8_SB(0, 1), b2 + hstep, voffB);
            PG8_WAIT_V(6); PG8_BAR; PG8_MMA(1, 1, At, B1); PG8_BAR;
            PG8_LDB(B0, 1, 0); PG8_SCHED; PG8_LDA(At, 1, 0); PG8_STAGE(PG8_SA(0, 1), a2 + hstep, voffA);
            PG8_WAIT_L(8); PG8_BAR; PG8_WAIT_L(0); PG8_MMA(0, 0, At, B0); PG8_BAR; PG8_SCHED;
            PG8_LDB(B1, 1, 1); PG8_STAGE(PG8_SB(1, 0), b3, voffB);
            PG8_BAR; PG8_WAIT_L(0); PG8_MMA(0, 1, At, B1); PG8_BAR;
            PG8_LDA(At, 1, 1); PG8_STAGE(PG8_SA(1, 0), a3, voffA);
            PG8_BAR; PG8_WAIT_L(0); PG8_MMA(1, 0, At, B0); PG8_BAR; PG8_SCHED;
            PG8_STAGE(PG8_SB(1, 1), b3 + hstep, voffB);
            PG8_WAIT_V(6); PG8_BAR; PG8_MMA(1, 1, At, B1); PG8_BAR;
            }
        }
        if constexpr (ALIGN_EPI) { if (wr == 0) PG8_BAR; }
        if constexpr (!Epi::AFTER_DRAIN) { E(acc, cur, wr, wc, fr, fq); S.done(cur); }
        if (!has_next) break;
#pragma unroll
        for (int a = 0; a < 2; ++a)
#pragma unroll
            for (int b = 0; b < 2; ++b)
#pragma unroll
                for (int m = 0; m < 4; ++m)
#pragma unroll
                    for (int n = 0; n < 2; ++n) acc[a][b][m][n] = (f32x4){0.f, 0.f, 0.f, 0.f};
        cur = nxt; cA = nA; cB = nB; ++ui;
        if constexpr (ALIGN_EPI) { if (wr == 1) PG8_BAR; }
    }
    PG8_WAIT_V(0);
    if constexpr (!ALIGN_EPI) { if (wr == 0) PG8_BAR; }
    PG8_BAR;
    if constexpr (Epi::AFTER_DRAIN) { E.fused(acc, cur, wr, wc, fr, fq, lds, wid, lane); S.done(cur); }
#undef PG8_SA
#undef PG8_SB
#undef PG8_STAGE
#undef PG8_LDA
#undef PG8_LDB
#undef PG8_MMA
#undef PG8_WAIT_V
#undef PG8_WAIT_L
#undef PG8_BAR
#undef PG8_SCHED
}
}

#ifndef PG8_SP2
#define PG8_SP2 true
#endif
#ifndef PG8_ALIGN
#define PG8_ALIGN true
#endif
#include <hip/hip_bf16.h>
#include <cmath>
namespace attn_body {
using bf16=__hip_bfloat16;
using bf16x8=__attribute__((ext_vector_type(8)))short;
using s16x4=__attribute__((ext_vector_type(4)))short;
using f32x16=__attribute__((ext_vector_type(16)))float;
using u32x4=__attribute__((ext_vector_type(4)))unsigned;
constexpr int BATCH=4,NHEAD=8,SEQ=4096,D=64,QP=512,KP=128,OP=1024;
constexpr int NW=8,QBLK=32,QB=QBLK*NW,KVBLK=64,NQB=SEQ/QB;
constexpr int ATTN_UNIT_ROWS=QB;
__device__ __forceinline__ int crow(int r,int hi){return (r&3)+8*(r>>2)+4*hi;}
#define SBAR() __builtin_amdgcn_sched_barrier(0)
__device__ __forceinline__ void cmask(f32x16&p0,f32x16&p1,int jb,int qrel,int hi){
  const float NEG=-INFINITY; int kb=64*jb+4*hi;
  #pragma unroll
  for(int r=0;r<16;++r){int kv=kb+(r&3)+8*(r>>2); if(kv>qrel)p0[r]=NEG; if(kv+32>qrel)p1[r]=NEG;}
}

constexpr int NSLOT=3, SLOTB=8192;
constexpr int LDS_K=0, LDS_V=NSLOT*SLOTB, LDS_WS=2*NSLOT*SLOTB, LDS_OST=LDS_WS+NW*64*4, LDS_BYTES=LDS_OST+NW*4096;
constexpr float C2=0.125f*1.4426950408889634f;
__device__ __forceinline__ void glds16(const void*gsrc,unsigned lds_dst){unsigned keep;
  asm volatile("s_mov_b32 %0, m0\n\ts_mov_b32 m0, %2\n\ts_nop 0\n\tglobal_load_lds_dwordx4 %1, off\n\ts_mov_b32 m0, %0":"=&s"(keep):"v"(gsrc),"s"(lds_dst):"memory");}
__device__ __forceinline__ float max3f(float a,float b,float c){float r;asm("v_max3_f32 %0, %1, %2, %3":"=v"(r):"v"(a),"v"(b),"v"(c));return r;}
__device__ __forceinline__ float max2f(float a,float b){float r;asm("v_max_f32_e32 %0, %1, %2":"=v"(r):"v"(a),"v"(b));return r;}
__device__ __forceinline__ float fadd_s(float a,float b){float r;asm("v_add_f32_e32 %0, %1, %2":"=v"(r):"v"(a),"v"(b));return r;}
__device__ __forceinline__ float fsub_s(float a,float b){float r;asm("v_sub_f32_e32 %0, %1, %2":"=v"(r):"v"(a),"v"(b));return r;}
typedef float f32x2_t __attribute__((ext_vector_type(2))); typedef __bf16 bf16x2_t __attribute__((ext_vector_type(2)));
__device__ __forceinline__ unsigned cvtpk_s(float lo,float hi){f32x2_t v={lo,hi};bf16x2_t b=__builtin_convertvector(v,bf16x2_t);return __builtin_bit_cast(unsigned,b);}
#define WAIT_BAR(N) asm volatile("s_waitcnt vmcnt(" #N ") lgkmcnt(0)\n\ts_barrier":::"memory")

__device__ __forceinline__ void qkt(f32x16&p0,f32x16&p1,const char*Kslot,const bf16x8*qr,const f32x16&negm,int r32,int hi){
  const char*kb=Kslot+hi*1024+r32*16;
  #pragma unroll
  for(int d0=0;d0<4;++d0){
    const bf16x8 b0=*reinterpret_cast<const bf16x8*>(kb+d0*2048);
    const bf16x8 b1=*reinterpret_cast<const bf16x8*>(kb+d0*2048+512);
    if(d0==0){p0=__builtin_amdgcn_mfma_f32_32x32x16_bf16(b0,qr[0],negm,0,0,0);p1=__builtin_amdgcn_mfma_f32_32x32x16_bf16(b1,qr[0],negm,0,0,0);}
    else{p0=__builtin_amdgcn_mfma_f32_32x32x16_bf16(b0,qr[d0],p0,0,0,0);p1=__builtin_amdgcn_mfma_f32_32x32x16_bf16(b1,qr[d0],p1,0,0,0);}}
}
typedef __attribute__((address_space(3))) const char* lds_cptr;
typedef short v4i16_t __attribute__((ext_vector_type(4)));
__device__ __forceinline__ void kload8(bf16x8*kf,lds_cptr kp){
  kf[0]=*(const __attribute__((address_space(3))) bf16x8*)(kp);      kf[1]=*(const __attribute__((address_space(3))) bf16x8*)(kp+512);
  kf[2]=*(const __attribute__((address_space(3))) bf16x8*)(kp+2048); kf[3]=*(const __attribute__((address_space(3))) bf16x8*)(kp+2560);
  kf[4]=*(const __attribute__((address_space(3))) bf16x8*)(kp+4096); kf[5]=*(const __attribute__((address_space(3))) bf16x8*)(kp+4608);
  kf[6]=*(const __attribute__((address_space(3))) bf16x8*)(kp+6144); kf[7]=*(const __attribute__((address_space(3))) bf16x8*)(kp+6656);
}
__device__ __forceinline__ void kload2(bf16x8*kf,lds_cptr kp,int j){ kf[2*j]=*(const __attribute__((address_space(3))) bf16x8*)(kp+j*2048); kf[2*j+1]=*(const __attribute__((address_space(3))) bf16x8*)(kp+j*2048+512); }
__device__ __forceinline__ s16x4 vtr(lds_cptr p){ return __builtin_bit_cast(s16x4,__builtin_amdgcn_ds_read_tr16_b64_v4i16((__attribute__((address_space(3))) v4i16_t*)p)); }
__device__ __forceinline__ float rowmax(const f32x16&p0,const f32x16&p1){
  float a=max3f(p0[0],p0[1],p1[0]),b=max3f(p0[2],p0[3],p1[1]);a=max3f(a,p1[2],p1[3]);
  #pragma unroll
  for(int r=4;r<16;r+=4){a=max3f(a,p0[r],p0[r+1]);b=max3f(b,p0[r+2],p0[r+3]);a=max3f(a,p1[r],p1[r+1]);b=max3f(b,p1[r+2],p1[r+3]);}
  const float m=max2f(a,b);
  auto rr=__builtin_amdgcn_permlane32_swap(__float_as_uint(m),__float_as_uint(m),false,false);
  return max2f(__uint_as_float(rr[0]),__uint_as_float(rr[1]));
}
__device__ __forceinline__ void pv(f32x16*o,int vb,bf16x8 pa0,bf16x8 pa1,bf16x8 pa2,bf16x8 pa3){
  #pragma unroll
  for(int d0=0;d0<2;++d0){s16x4 lo[4],hi[4];
    #pragma unroll
    for(int ks=0;ks<4;++ks){
      asm volatile("ds_read_b64_tr_b16 %0,%1 offset:%c2":"=&v"(lo[ks]):"v"(vb),"i"(d0*4096+ks*1024):"memory");
      asm volatile("ds_read_b64_tr_b16 %0,%1 offset:%c2":"=&v"(hi[ks]):"v"(vb),"i"(d0*4096+ks*1024+512):"memory");}
    asm volatile("s_waitcnt lgkmcnt(0)":::"memory");SBAR();
    #define PK(k) (bf16x8){lo[k][0],lo[k][1],lo[k][2],lo[k][3],hi[k][0],hi[k][1],hi[k][2],hi[k][3]}
    o[d0]=__builtin_amdgcn_mfma_f32_32x32x16_bf16(pa0,PK(0),o[d0],0,0,0);
    o[d0]=__builtin_amdgcn_mfma_f32_32x32x16_bf16(pa1,PK(1),o[d0],0,0,0);
    o[d0]=__builtin_amdgcn_mfma_f32_32x32x16_bf16(pa2,PK(2),o[d0],0,0,0);
    o[d0]=__builtin_amdgcn_mfma_f32_32x32x16_bf16(pa3,PK(3),o[d0],0,0,0);
    #undef PK
  }
}

#ifndef ATTN_STORE16
#define ATTN_STORE16(p,v) (*(u32x4*)(p)=(v))
#endif
template<int THRL> __device__ __forceinline__ void attn_unit(int b,int h,int qb,const bf16*Q,const bf16*__restrict__ K,const bf16*__restrict__ V,bf16*O,char*shm){
  const int tid=threadIdx.x,lane=tid&63,r32=lane&31,hi=lane>>5; const int wid=__builtin_amdgcn_readfirstlane(tid>>6);
  const long rowbase=(long)b*SEQ; const int q0=qb*QB;
  const bf16*Qw=Q+(rowbase+q0+wid*QBLK)*QP+h*D;
  const bf16*Kh=K+rowbase*KP+(h>>2)*D,*Vh=V+rowbase*KP+(h>>2)*D;
  const unsigned lds0=(unsigned)(uintptr_t)shm;
  float*wsf=(float*)(shm+LDS_WS)+wid*64;
  const bf16*ksrc=Kh+(long)lane*KP+wid*8;
  const bf16*vsrc=Vh+(long)(16*(wid&3)+(lane>>2))*KP+(wid>>2)*32+(lane&3)*8;
  const unsigned kdst=lds0+LDS_K+wid*1024, vdst=lds0+LDS_V+wid*1024;
  #define DMA_K(t,slot) glds16(ksrc+(long)(t)*KVBLK*KP,(unsigned)__builtin_amdgcn_readfirstlane(kdst+(slot)))
  #define DMA_V(t,slot) glds16(vsrc+(long)(t)*KVBLK*KP,(unsigned)__builtin_amdgcn_readfirstlane(vdst+(slot)))
  const int vb0=(int)(lds0+LDS_V)+((lane>>4)&1)*32+(lane&3)*8+(4*hi+((lane&15)>>2))*64;
  const char*Kbase=shm+LDS_K; bf16x8 kf[8];
  const lds_cptr shm3=(lds_cptr)shm; const lds_cptr kp0=shm3+LDS_K+hi*1024+r32*16; const lds_cptr vp0=shm3+LDS_V+((lane>>4)&1)*32+(lane&3)*8+(4*hi+((lane&15)>>2))*64;
  const int NT=SEQ/KVBLK;
  DMA_K(0,0);DMA_V(0,0);DMA_K(1,SLOTB);
  bf16x8 qr[4];
  #pragma unroll
  for(int d0=0;d0<4;++d0)qr[d0]=*reinterpret_cast<const bf16x8*>(&Qw[(long)r32*QP+d0*16+hi*8]);
  float mhat=0.f,l_reg=0.f;f32x16 o[2];o[0]=f32x16{};o[1]=f32x16{};f32x16 negm=f32x16{};asm volatile("":"+v"(negm));
  const int qrel=wid*QBLK+r32;
  #define CMASK(P0,P1,t) do{}while(0)
  bool resc=false;
  #define START(P0,P1) do{ const float rm=rowmax(P0,P1); resc=false; \
    { const float dl=rm; mhat=fadd_s(mhat,dl); \
      _Pragma("unroll") for(int r=0;r<16;++r){P0[r]=fsub_s(P0[r],dl);P1[r]=fsub_s(P1[r],dl);} \
      _Pragma("unroll") for(int r=0;r<16;++r)negm[r]=-mhat; asm volatile("":"+v"(negm)); } \
    _Pragma("unroll") for(int r=0;r<16;++r)P0[r]=__builtin_amdgcn_exp2f(P0[r]); }while(0)
  #define RESC() do{ if(resc){ asm volatile("s_waitcnt lgkmcnt(0)":::"memory"); \
      _Pragma("unroll") for(int d_=0;d_<2;++d_) _Pragma("unroll") for(int r=0;r<16;++r)o[d_][r]*=wsf[crow(r,hi)]; } }while(0)
  f32x16 pA0,pA1,pB0,pB1;
  int sl_prev=0,sl_cur=0,sl_next=SLOTB;
  #define ROT() do{sl_prev=sl_cur;sl_cur=sl_next;sl_next=(sl_next==(NSLOT-1)*SLOTB)?0:sl_next+SLOTB;}while(0)
  DMA_K(2,2*SLOTB);
  WAIT_BAR(3);
  qkt(pA0,pA1,Kbase,qr,negm,r32,hi);asm volatile("s_nop 15\n\ts_nop 7":"+v"(pA0),"+v"(pA1));CMASK(pA0,pA1,0);
  START(pA0,pA1);
  _Pragma("unroll") for(int r=0;r<16;++r)pA1[r]=__builtin_amdgcn_exp2f(pA1[r]);
  WAIT_BAR(0);
  DMA_K(3,0);DMA_V(1,SLOTB);
  ROT();
  kload8(kf,kp0+sl_cur);
  WAIT_BAR(2);
  s16x4 vlo[8],vhi[8]; u32x4 pw0,pw1,pw2,pw3;
  #define PKW(P,B) cvtpk_s(P[B],P[B+1])
  #define PAF(k) __builtin_bit_cast(bf16x8,pw##k)
  #define VFR(i) (bf16x8){vlo[i][0],vlo[i][1],vlo[i][2],vlo[i][3],vhi[i][0],vhi[i][1],vhi[i][2],vhi[i][3]}
  #define PIN(x) asm volatile("":"+v"(x))
  #define MX3(a,b,c) __builtin_fmaxf(__builtin_fmaxf((a),(b)),(c))
  #define GAPA(MF,A0,A1,A2,A3,W0,W1,PW) do{ MF; sacc+=A0; sacc+=A1; sacc+=A2; sacc+=A3; PIN(sacc); W0; W1; PIN(PW); SBAR(); }while(0)
  #define EX(v) __builtin_amdgcn_exp2f(v)
  #define GAPB(MF,X,B) do{ MF; X[B]=EX(X[B]); X[B+1]=EX(X[B+1]); X[B+2]=EX(X[B+2]); X[B+3]=EX(X[B+3]); PIN(X); SBAR(); }while(0)
  #define VRD(i) do{ vlo[i]=vtr(vp_+(((i)>>2)*4096+((i)&3)*1024)); vhi[i]=vtr(vp_+(((i)>>2)*4096+((i)&3)*1024+512)); }while(0)
  #define KRD(G,j) do{ if(G){ kload2(kf,kp0+sl_next,j); SBAR(); } }while(0)
  #define STEP(C0,C1,P0,P1,t,GK,GV,GL) do{ SBAR(); \
    const lds_cptr vp_=vp0+sl_prev; \
    VRD(0); SBAR(); float sacc=(P0[0]+P0[1]); \
    GAPA(C0=__builtin_amdgcn_mfma_f32_32x32x16_bf16(kf[0],qr[0],negm,0,0,0), P0[2],P0[3],P0[4],P0[5],     pw0[0]=PKW(P0,0), pw0[1]=PKW(P0,2), pw0); \
    VRD(4); SBAR(); GAPA(C1=__builtin_amdgcn_mfma_f32_32x32x16_bf16(kf[1],qr[0],negm,0,0,0), P0[6],P0[7],P0[8],P0[9],     pw0[2]=PKW(P0,4), pw0[3]=PKW(P0,6), pw0); \
    VRD(1); SBAR(); GAPA(C0=__builtin_amdgcn_mfma_f32_32x32x16_bf16(kf[2],qr[1],C0,0,0,0),   P0[10],P0[11],P0[12],P0[13], pw1[0]=PKW(P0,8), pw1[1]=PKW(P0,10), pw1); \
    VRD(5); SBAR(); GAPA(C1=__builtin_amdgcn_mfma_f32_32x32x16_bf16(kf[3],qr[1],C1,0,0,0),   P0[14],P0[15],P1[0],P1[1],   pw1[2]=PKW(P0,12),pw1[3]=PKW(P0,14), pw1); \
    VRD(2); SBAR(); GAPA(C0=__builtin_amdgcn_mfma_f32_32x32x16_bf16(kf[4],qr[2],C0,0,0,0),   P1[2],P1[3],P1[4],P1[5],     pw2[0]=PKW(P1,0), pw2[1]=PKW(P1,2), pw2); \
    VRD(6); SBAR(); GAPA(C1=__builtin_amdgcn_mfma_f32_32x32x16_bf16(kf[5],qr[2],C1,0,0,0),   P1[6],P1[7],P1[8],P1[9],     pw2[2]=PKW(P1,4), pw2[3]=PKW(P1,6), pw2); \
    VRD(3); SBAR(); GAPA(C0=__builtin_amdgcn_mfma_f32_32x32x16_bf16(kf[6],qr[3],C0,0,0,0),   P1[10],P1[11],P1[12],P1[13], pw3[0]=PKW(P1,8), pw3[1]=PKW(P1,10), pw3); \
    VRD(7); SBAR(); GAPA(C1=__builtin_amdgcn_mfma_f32_32x32x16_bf16(kf[7],qr[3],C1,0,0,0),   P1[14],P1[15],0.f,0.f,       pw3[2]=PKW(P1,12),pw3[3]=PKW(P1,14), pw3); \
    l_reg+=sacc; \
    if(GK){DMA_K((t)+3,sl_cur);} if(GV){DMA_V((t)+1,sl_next);} \
    CMASK(C0,C1,t); \
    { float a=MX3(C0[0],C0[1],C1[0]),b=MX3(C0[2],C0[3],C1[1]); a=MX3(a,C1[2],C1[3]); \
      _Pragma("unroll") for(int r=4;r<16;r+=4){a=MX3(a,C0[r],C0[r+1]);b=MX3(b,C0[r+2],C0[r+3]);a=MX3(a,C1[r],C1[r+1]);b=MX3(b,C1[r+2],C1[r+3]);} \
      float rm=__builtin_fmaxf(a,b); { auto rr=__builtin_amdgcn_permlane32_swap(__float_as_uint(rm),__float_as_uint(rm),false,false); rm=__builtin_fmaxf(__uint_as_float(rr[0]),__uint_as_float(rr[1])); } \
      resc=false; \
      if(__builtin_expect(__any(rm>(float)THRL),0)){ const float dl=__builtin_fmaxf(rm,0.f); mhat+=dl; \
        _Pragma("unroll") for(int r=0;r<16;++r){C0[r]-=dl;C1[r]-=dl;} \
        _Pragma("unroll") for(int r=0;r<16;++r)negm[r]=-mhat; asm volatile("":"+v"(negm)); \
        const float f=__builtin_amdgcn_exp2f(-dl); l_reg*=f; if(hi==0)wsf[r32]=f; resc=true; } } \
    SBAR(); \
    GAPB(o[0]=__builtin_amdgcn_mfma_f32_32x32x16_bf16(PAF(0),VFR(0),o[0],0,0,0), C0,0); \
    GAPB(o[1]=__builtin_amdgcn_mfma_f32_32x32x16_bf16(PAF(0),VFR(4),o[1],0,0,0), C0,4); \
    KRD(GL,0); GAPB(o[0]=__builtin_amdgcn_mfma_f32_32x32x16_bf16(PAF(1),VFR(1),o[0],0,0,0), C0,8); \
    KRD(GL,1); GAPB(o[1]=__builtin_amdgcn_mfma_f32_32x32x16_bf16(PAF(1),VFR(5),o[1],0,0,0), C0,12); \
    KRD(GL,2); GAPB(o[0]=__builtin_amdgcn_mfma_f32_32x32x16_bf16(PAF(2),VFR(2),o[0],0,0,0), C1,0); \
    KRD(GL,3); GAPB(o[1]=__builtin_amdgcn_mfma_f32_32x32x16_bf16(PAF(2),VFR(6),o[1],0,0,0), C1,4); \
    GAPB(o[0]=__builtin_amdgcn_mfma_f32_32x32x16_bf16(PAF(3),VFR(3),o[0],0,0,0), C1,8); \
    GAPB(o[1]=__builtin_amdgcn_mfma_f32_32x32x16_bf16(PAF(3),VFR(7),o[1],0,0,0), C1,12); \
    }while(0)
  int t=1;
  #undef CMASK
  #define CMASK(P0,P1,t) do{}while(0)
  for(;t+5<NT;t+=2){
    STEP(pB0,pB1,pA0,pA1,t,true,true,true);     WAIT_BAR(2); RESC(); ROT();
    STEP(pA0,pA1,pB0,pB1,t+1,true,true,true);   WAIT_BAR(2); RESC(); ROT();
  }
  #undef CMASK
  #define CMASK(P0,P1,t) do{}while(0)
  #define ENDW(tt) do{ if((tt)+3<NT){WAIT_BAR(2);} else if((tt)+2<NT){WAIT_BAR(1);} else {WAIT_BAR(0);} }while(0)
  for(;t+1<NT;t+=2){
    STEP(pB0,pB1,pA0,pA1,t,(t+3<NT),(t+1<NT),(t+1<NT));       ENDW(t);   RESC(); ROT();
    STEP(pA0,pA1,pB0,pB1,t+1,(t+4<NT),(t+2<NT),(t+2<NT));     ENDW(t+1); RESC(); ROT();
  }
  STEP(pB0,pB1,pA0,pA1,NT-1,false,false,false); RESC();
  { float sacc=pB0[0]+pB0[1]; _Pragma("unroll") for(int r=2;r<16;++r)sacc+=pB0[r]; _Pragma("unroll") for(int r=0;r<16;++r)sacc+=pB1[r]; l_reg+=sacc;
    pw0=(u32x4){PKW(pB0,0),PKW(pB0,2),PKW(pB0,4),PKW(pB0,6)};pw1=(u32x4){PKW(pB0,8),PKW(pB0,10),PKW(pB0,12),PKW(pB0,14)};pw2=(u32x4){PKW(pB1,0),PKW(pB1,2),PKW(pB1,4),PKW(pB1,6)};pw3=(u32x4){PKW(pB1,8),PKW(pB1,10),PKW(pB1,12),PKW(pB1,14)};
    SBAR(); pv(o,vb0+sl_cur,PAF(0),PAF(1),PAF(2),PAF(3)); }
  #undef PKW
  #undef PAF
  #undef VFR
  #undef PIN
  #undef MX3
  #undef GAPA
  #undef GAPB
  #undef EX
  #undef VRD
  #undef KRD
  #undef STEP
  #undef ENDW
  {auto rr=__builtin_amdgcn_permlane32_swap(__float_as_uint(l_reg),__float_as_uint(l_reg),false,false);l_reg=__uint_as_float(rr[0])+__uint_as_float(rr[1]);}
  if(hi==0)wsf[32+r32]=l_reg;asm volatile("s_waitcnt lgkmcnt(0)":::"memory");
  float rli[16];
  #pragma unroll
  for(int r=0;r<16;++r)rli[r]=__builtin_amdgcn_rcpf(wsf[32+crow(r,hi)]);
  bf16*Ow=O+(rowbase+q0+wid*QBLK)*OP+h*D;
  { bf16*stg=(bf16*)(shm+LDS_OST)+wid*2048;
    #pragma unroll
    for(int r=0;r<16;++r){const int orow=crow(r,hi);
      #pragma unroll
      for(int d0=0;d0<2;++d0)stg[orow*64+d0*32+r32]=__float2bfloat16(o[d0][r]*rli[r]);}
    asm volatile("s_waitcnt lgkmcnt(0)":::"memory");
    #pragma unroll
    for(int i=0;i<4;++i){const int row=i*8+(lane>>3),ch=lane&7; const u32x4 v=*(const u32x4*)(stg+row*64+ch*8); ATTN_STORE16(Ow+(long)row*OP+ch*8,v);} }
  asm volatile("s_waitcnt lgkmcnt(0)\n\ts_barrier":::"memory");
  #undef DMA_K
  #undef DMA_V
  #undef CMASK
  #undef START
  #undef RESC
  #undef ROT
}
constexpr int ATTN_LDS_BYTES=LDS_BYTES;
struct AttnTensors { const bf16* Q; const bf16* K; const bf16* V; bf16* O; };
struct AttnUnit { int b; int h; int qb; };
struct StaticOrder {
  int vcu;
  __device__ __forceinline__ explicit StaticOrder(int vcu_):vcu(vcu_){}
  __device__ __forceinline__ bool next(int i,AttnUnit&u)const{ if(i>=2)return false; const int pr=vcu>>5, lc=vcu&31; u.b=pr>>1; u.h=(pr&1)*4+(lc>>3); u.qb=(lc&7)*2+i; return true; }
};
template<int THRL=8> __device__ __forceinline__ void attn_phase(char*lds,const AttnTensors&T,const StaticOrder&S){
  AttnUnit u;
  for(int i=0;S.next(i,u);++i){ attn_unit<THRL>(u.b,u.h,u.qb,T.Q,T.K,T.V,T.O,lds); }
}
#undef SBAR
#undef WAIT_BAR
}
#define GAS __attribute__((address_space(1)))
#define LAS __attribute__((address_space(3)))
typedef unsigned short bf16;
typedef unsigned v4u __attribute__((ext_vector_type(4)));
typedef float f32x4 __attribute__((ext_vector_type(4)));
typedef short bf16x8 __attribute__((ext_vector_type(8)));
typedef GAS unsigned gu32;
typedef GAS unsigned long long gu64;
#define RLX_AGENT __ATOMIC_RELAXED, __HIP_MEMORY_SCOPE_AGENT
#define LDS_WAIT() asm volatile("s_waitcnt lgkmcnt(0)" ::: "memory")
#define VM_WAIT() asm volatile("s_waitcnt vmcnt(0)" ::: "memory")
__device__ __forceinline__ unsigned long long rt() { return __builtin_amdgcn_s_memrealtime(); }
__device__ __forceinline__ unsigned pk2(float lo, float hi) { return f2bf(lo) | (f2bf(hi) << 16); }

#define XB_TMO      128
#define XB_XCNT(j)  (256  + 64 * (j))
#define XB_XSUB(j)  (1280 + 64 * (j))
#define XB_XGEN(j)  (2304 + 64 * (j))
#define XB_TOP      3328
#define XB_TOPGEN   3392
#define XCD_BAR_WORDS 3456
#define XB_SPIN_CAP (1u << 18)

__device__ __forceinline__ unsigned xb_ld(unsigned* p)              { return __hip_atomic_load(p, __ATOMIC_RELAXED, __HIP_MEMORY_SCOPE_AGENT); }
__device__ __forceinline__ unsigned xb_add(unsigned* p, unsigned v) { return __hip_atomic_fetch_add(p, v, __ATOMIC_RELAXED, __HIP_MEMORY_SCOPE_AGENT); }
__device__ __forceinline__ unsigned xb_xcc_id() { return (unsigned)__builtin_amdgcn_s_getreg((3 << 11) | 20) & 0xFu; }
#define XB_SPIN(cond, bar) do { unsigned _sp = 0; while (cond) { __builtin_amdgcn_s_sleep(1); \
    if ((++_sp & 255u) == 0u) { if (xb_ld(&(bar)[XB_TMO])) break; if (_sp > XB_SPIN_CAP) { atomicAdd(&(bar)[XB_TMO], 1u); break; } } } } while (0)

struct XcdBarrier {
    unsigned* bar; unsigned x;
    volatile LAS unsigned* st;
};

__device__ __forceinline__ XcdBarrier xcd_barrier_post(unsigned* bar, volatile LAS unsigned* st) {
    XcdBarrier b; b.bar = bar; b.x = xb_xcc_id(); b.st = st;
    if (threadIdx.x == 0) (void)xb_add(&bar[XB_XCNT(b.x)], 1u);
    return b;
}
__device__ __forceinline__ void xcd_barrier_complete(unsigned* bar, unsigned x, unsigned& nloc, unsigned& nx) {
    const unsigned G = gridDim.x * gridDim.y * gridDim.z;
    unsigned sum, cnt, mine, sp = 0u;
    for (;;) {
        sum = 0u; cnt = 0u; mine = 0u;
#pragma unroll
        for (unsigned j = 0; j < 16; ++j) { const unsigned c = xb_ld(&bar[XB_XCNT(j)]); sum += c; cnt += (c > 0u) ? 1u : 0u; mine = (j == x) ? c : mine; }
        if (sum == G) break;
        __builtin_amdgcn_s_sleep(1);
        if ((++sp & 255u) == 0u) { if (xb_ld(&bar[XB_TMO])) break; if (sp > XB_SPIN_CAP) { atomicAdd(&bar[XB_TMO], 1u); break; } }
    }
    nloc = mine > 0u ? mine : 1u; nx = cnt > 0u ? cnt : 1u;
}

__device__ __forceinline__ void xcd_barrier(const XcdBarrier& b) {
    asm volatile("s_waitcnt vmcnt(0)" ::: "memory");
    __syncthreads();
    if (threadIdx.x == 0) {
        unsigned* bar = b.bar;
        __builtin_amdgcn_s_waitcnt(0);
        unsigned nloc = b.st[0], nx = b.st[1];
        if (nloc == 0u) { xcd_barrier_complete(bar, b.x, nloc, nx); b.st[0] = nloc; b.st[1] = nx; }
        const unsigned old = xb_add(&bar[XB_XSUB(b.x)], 1u);
        const unsigned gen = old / nloc;
        if (old + 1u == (gen + 1u) * nloc) {
            __builtin_amdgcn_fence(__ATOMIC_RELEASE, "agent");
            asm volatile("s_waitcnt vmcnt(0)" ::: "memory");
            const unsigned og = xb_add(&bar[XB_TOP], 1u);
            const unsigned tg = og / nx;
            if (og + 1u == (tg + 1u) * nx) xb_add(&bar[XB_TOPGEN], 1u);
            else XB_SPIN(xb_ld(&bar[XB_TOPGEN]) == tg, bar);
            __builtin_amdgcn_fence(__ATOMIC_ACQUIRE, "agent");
            xb_add(&bar[XB_XGEN(b.x)], 1u);
            asm volatile("s_waitcnt vmcnt(0)" ::: "memory");
        } else {
            XB_SPIN(xb_ld(&bar[XB_XGEN(b.x)]) == gen, bar);
            __builtin_amdgcn_fence(__ATOMIC_ACQUIRE, "agent");
            asm volatile("s_waitcnt vmcnt(0)" ::: "memory");
        }
    }
    __syncthreads();
}
constexpr int NWAVES = 8;
constexpr int RING_OFF = 0, RING_BYTES = 131072;
constexpr int LDSCTL_OFF = RING_BYTES, MISC_OFF = LDSCTL_OFF + 320;
constexpr int LDS_BYTES = 147456;
constexpr int CW_BAR = 4096;
static_assert((CW_BAR + 8 * XCD_BAR_WORDS) * 4 <= (int)CTL_ZERO_BYTES, "barrier regions inside the memset");

struct Frame {
    LAS unsigned char* lds;
    volatile LAS unsigned* MISC;
    gu32* ctl;
    int tid, lane, wave, vcu, G;
    const float* in[23]; float* out; unsigned char* ws;
};

__device__ __forceinline__ float wave_sum(float v) {
#pragma unroll
    for (int o = 1; o < 64; o <<= 1) v += __shfl_xor(v, o);
    return v;
}
namespace lru {
typedef float f32x2 __attribute__((ext_vector_type(2)));
constexpr int CH = 64, NCH = SEQ / CH;
constexpr int XCF_STRIDE = 68, XCB_STRIDE = 72;
constexpr int L_AU = 0, L_XCF = 65536, L_XCB = L_XCF + 64 * XCF_STRIDE * 4, L_SUB = L_XCB + 64 * XCB_STRIDE * 2, L_CAR = L_SUB + 4096, L_END = L_CAR + 4096;
static_assert(L_END <= RING_BYTES, "LRU scratch");
constexpr float LOG2E = 1.4426950408889634f;

__device__ __forceinline__ void pass1(Frame& F) {
    const int tid = F.tid, lane = F.lane, w = F.wave;
    LAS unsigned char* sh = F.lds + RING_OFF;
    LAS f32x2* AU = (LAS f32x2*)(sh + L_AU); LAS float* XCF = (LAS float*)(sh + L_XCF); LAS bf16* XCB = (LAS bf16*)(sh + L_XCB);
    LAS f32x2* SUB = (LAS f32x2*)(sh + L_SUB); LAS f32x2* CAR = (LAS f32x2*)(sh + L_CAR);
    unsigned char* ws = F.ws;
    const bf16* XR = (const bf16*)(ws + WS_XR); bf16* SL = (bf16*)(ws + WS_SL); bf16* PF = (bf16*)(ws + WS_PF); bf16* PB = (bf16*)(ws + WS_PBK);
    f32x2* AGG = (f32x2*)(ws + WS_AGG); const bf16* LW = (const bf16*)(ws + WS_LW);
    const int cu = F.vcu & 255, b = cu >> 6, n = (cu >> 3) & 7, oct = cu & 7;
    const int cc = tid & 63, tq = tid >> 6;
    const float* cw = F.in[6];
    const float w0 = cw[n * 64 + cc], w1 = cw[512 + n * 64 + cc], w2 = cw[1024 + n * 64 + cc], w3 = cw[1536 + n * 64 + cc], cbv = F.in[7][n * 64 + cc];
    const int ge = w >> 2, gj = (w & 3) * 16 + (lane & 15), gq = lane >> 4, gc = ge * 512 + n * 64 + gj;
    const float bav = F.in[9][gc], bxv = F.in[11][gc];
    const float k8 = 8.0f * (-log1pf(expf(-F.in[12][gc]))) * LOG2E;
    bf16x8 bfr[2][2];
#pragma unroll
    for (int g = 0; g < 2; ++g)
#pragma unroll
        for (int ks = 0; ks < 2; ++ks) bfr[g][ks] = *(const bf16x8*)(LW + ((size_t)(n * 256 + ge * 128 + g * 64 + gj)) * 64 + ks * 32 + 8 * gq);
    const int sc = tid & 63, se = (tid >> 6) & 1, ssub = tid >> 7, scol = se * 64 + sc;
    bf16 xraw[11];
#define LRU_LOADX(chunk_) do { const int t0_ = (chunk_) * CH; _Pragma("unroll") for (int r = 0; r < 11; ++r) { const int tt = t0_ + tq * 8 - 2 + r; \
        xraw[r] = (tt >= 0 && tt < SEQ) ? XR[((size_t)b * SEQ + tt) * DLRU + n * 64 + cc] : (bf16)0; } } while (0)
    LRU_LOADX(oct * 8);
    for (int ci = 0; ci < 8; ++ci) {
        const int chunk = oct * 8 + ci, t0 = chunk * CH; const size_t row0 = (size_t)b * SEQ + t0;
        __syncthreads();
        {
            float xv[11];
#pragma unroll
            for (int r = 0; r < 11; ++r) xv[r] = bf2f(xraw[r]);
            if (ci < 7) LRU_LOADX(chunk + 1);
#pragma unroll
            for (int i = 0; i < 8; ++i) { const float xc = cbv + w0 * xv[i] + w1 * xv[i + 1] + w2 * xv[i + 2] + w3 * xv[i + 3]; const int t = tq * 8 + i;
                XCF[t * XCF_STRIDE + cc] = xc; XCB[t * XCB_STRIDE + cc] = (bf16)f2bf(xc); }
        }
        __syncthreads();
#pragma unroll
        for (int mb = 0; mb < 4; ++mb) {
            const LAS bf16* ap = XCB + (16 * mb + (lane & 15)) * XCB_STRIDE + 8 * gq;
            const bf16x8 a0 = *(const LAS bf16x8*)(ap), a1 = *(const LAS bf16x8*)(ap + 32);
            f32x4 ga = {0.f, 0.f, 0.f, 0.f}, gx = {0.f, 0.f, 0.f, 0.f};
            ga = __builtin_amdgcn_mfma_f32_16x16x32_bf16(a0, bfr[0][0], ga, 0, 0, 0); ga = __builtin_amdgcn_mfma_f32_16x16x32_bf16(a1, bfr[0][1], ga, 0, 0, 0);
            gx = __builtin_amdgcn_mfma_f32_16x16x32_bf16(a0, bfr[1][0], gx, 0, 0, 0); gx = __builtin_amdgcn_mfma_f32_16x16x32_bf16(a1, bfr[1][1], gx, 0, 0, 0);
#pragma unroll
            for (int r = 0; r < 4; ++r) {
                const int t = 16 * mb + 4 * gq + r; const float xc = XCF[t * XCF_STRIDE + gj];
                const float rg = __builtin_amdgcn_rcpf(1.0f + __builtin_amdgcn_exp2f(-LOG2E * (ga[r] + bav)));
                const float ig = __builtin_amdgcn_rcpf(1.0f + __builtin_amdgcn_exp2f(-LOG2E * (gx[r] + bxv)));
                const float a = __builtin_amdgcn_exp2f(k8 * rg);
                const float u = __builtin_amdgcn_sqrtf(fmaxf(fmaf(-a, a, 1.0f), 0.f)) * (ig * xc);
                AU[t * 128 + ge * 64 + gj] = (f32x2){a, u};
            }
        }
        __syncthreads();
        {
            float P = 1.f, h = 0.f; f32x2 au[16];
#pragma unroll
            for (int i = 0; i < 16; ++i) { const int t = se == 0 ? 16 * ssub + i : 16 * ssub + 15 - i; au[i] = AU[t * 128 + scol]; }
#pragma unroll
            for (int i = 0; i < 16; ++i) { h = au[i].x * h + au[i].y; P *= au[i].x; au[i] = (f32x2){P, h}; }
#pragma unroll
            for (int i = 0; i < 16; ++i) { const int t = se == 0 ? 16 * ssub + i : 16 * ssub + 15 - i; AU[t * 128 + scol] = au[i]; }
            SUB[ssub * 128 + scol] = (f32x2){P, h};
        }
        __syncthreads();
        {
            float cin = 0.f, pin = 1.f;
            if (se == 0) { for (int s2 = 0; s2 < ssub; ++s2) { const f32x2 ph = SUB[s2 * 128 + scol]; cin = ph.x * cin + ph.y; pin *= ph.x; } }
            else { for (int s2 = 3; s2 > ssub; --s2) { const f32x2 ph = SUB[s2 * 128 + scol]; cin = ph.x * cin + ph.y; pin *= ph.x; } }
            CAR[ssub * 128 + scol] = (f32x2){pin, cin};
            if ((se == 0 && ssub == 3) || (se == 1 && ssub == 0)) { const f32x2 ph = SUB[ssub * 128 + scol];
                AGG[((size_t)(b * NCH + chunk) * 2 + se) * DLRU + n * 64 + sc] = (f32x2){pin * ph.x, ph.y + ph.x * cin}; }
        }
        __syncthreads();
        {
            const int cp = tid & 31;
#pragma unroll
            for (int ps = 0; ps < 4; ++ps) {
                const int t = ps * 16 + (tid >> 5), sub = t >> 4;
                const f32x4 f = *(const LAS f32x4*)(AU + t * 128 + 2 * cp), bk = *(const LAS f32x4*)(AU + t * 128 + 64 + 2 * cp);
                const f32x4 cf = *(const LAS f32x4*)(CAR + sub * 128 + 2 * cp), cb = *(const LAS f32x4*)(CAR + sub * 128 + 64 + 2 * cp);
                const float hf0 = f[1] + f[0] * cf[1], hf1 = f[3] + f[2] * cf[3], pf0 = f[0] * cf[0], pf1 = f[2] * cf[2];
                const float hb0 = bk[1] + bk[0] * cb[1], hb1 = bk[3] + bk[2] * cb[3], pb0 = bk[0] * cb[0], pb1 = bk[2] * cb[2];
                const size_t o = (row0 + t) * DLRU + n * 64 + 2 * cp;
                *(unsigned*)(SL + o) = pk2(hf0 + hb0, hf1 + hb1); *(unsigned*)(PF + o) = pk2(pf0, pf1); *(unsigned*)(PB + o) = pk2(pb0, pb1);
            }
        }
    }
#undef LRU_LOADX
    __syncthreads();
}

__device__ __forceinline__ f32x4 lo4(const v4u w) { f32x4 v; v[0] = __uint_as_float(w.x << 16); v[1] = __uint_as_float(w.x & 0xffff0000u); v[2] = __uint_as_float(w.y << 16); v[3] = __uint_as_float(w.y & 0xffff0000u); return v; }
__device__ __forceinline__ f32x4 hi4(const v4u w) { f32x4 v; v[0] = __uint_as_float(w.z << 16); v[1] = __uint_as_float(w.z & 0xffff0000u); v[2] = __uint_as_float(w.w << 16); v[3] = __uint_as_float(w.w & 0xffff0000u); return v; }
__device__ __forceinline__ float sum8sq(const f32x4 a, const f32x4 b) { return ((a[0] * a[0] + a[1] * a[1]) + (a[2] * a[2] + a[3] * a[3])) + ((b[0] * b[0] + b[1] * b[1]) + (b[2] * b[2] + b[3] * b[3])); }
__device__ __forceinline__ v4u pack8(const f32x4 a, const f32x4 b) { v4u o; o.x = pk2(a[0], a[1]); o.y = pk2(a[2], a[3]); o.z = pk2(b[0], b[1]); o.w = pk2(b[2], b[3]); return o; }

template <bool ATT_HALF> __device__ __forceinline__ void pass2(Frame& F) {
    const int tid = F.tid;
    LAS unsigned char* sh = F.lds + RING_OFF;
    LAS f32x2* CFB = (LAS f32x2*)sh;
    unsigned char* ws = F.ws;
    const bf16* SL = (const bf16*)(ws + WS_SL); const bf16* PF = (const bf16*)(ws + WS_PF); const bf16* PB = (const bf16*)(ws + WS_PBK); const bf16* XG = (const bf16*)(ws + WS_XG);
    bf16* Y = (bf16*)(ws + WS_Y); const f32x2* AGG = (const f32x2*)(ws + WS_AGG);
    const float* gat = F.in[13]; const float* gl = F.in[14];
    const int cu = F.vcu & 255, b = cu >> 6, chunk = cu & 63; const size_t row0 = (size_t)b * SEQ + chunk * CH;
    {
        float cf = 0.f, cb = 0.f;
        for (int k = 0; k < chunk; ++k) { const f32x2 ah = AGG[((size_t)(b * NCH + k) * 2 + 0) * DLRU + tid]; cf = ah.x * cf + ah.y; }
        for (int k = NCH - 1; k > chunk; --k) { const f32x2 ah = AGG[((size_t)(b * NCH + k) * 2 + 1) * DLRU + tid]; cb = ah.x * cb + ah.y; }
        CFB[tid] = (f32x2){cf, cb};
    }
    __syncthreads();
    const int t = tid >> 3, l8 = tid & 7; const size_t row = row0 + t;
    {
        f32x4 y[8][2]; float s = 0.f;
#pragma unroll
        for (int k = 0; k < 8; ++k) {
            const int c0 = (l8 + 8 * k) * 8; const size_t o = row * DLRU + c0;
            const v4u sl = *(const GAS v4u*)(SL + o), pf = *(const GAS v4u*)(PF + o), pb = *(const GAS v4u*)(PB + o), xg = *(const GAS v4u*)(XG + o);
            const f32x4 c01 = *(const LAS f32x4*)(CFB + c0), c23 = *(const LAS f32x4*)(CFB + c0 + 2), c45 = *(const LAS f32x4*)(CFB + c0 + 4), c67 = *(const LAS f32x4*)(CFB + c0 + 6);
            const f32x4 cfl = {c01[0], c01[2], c23[0], c23[2]}, cbl = {c01[1], c01[3], c23[1], c23[3]}, cfh = {c45[0], c45[2], c67[0], c67[2]}, cbh = {c45[1], c45[3], c67[1], c67[3]};
            y[k][0] = (lo4(sl) + lo4(pf) * cfl + lo4(pb) * cbl) * lo4(xg); y[k][1] = (hi4(sl) + hi4(pf) * cfh + hi4(pb) * cbh) * hi4(xg);
            s += sum8sq(y[k][0], y[k][1]);
        }
        s += __shfl_xor(s, 1); s += __shfl_xor(s, 2); s += __shfl_xor(s, 4);
        const float rn = rsqrtf(s * (1.0f / DLRU) + EPS);
#pragma unroll
        for (int k = 0; k < 8; ++k) {
            const int c0 = (l8 + 8 * k) * 8; const f32x4 g0 = *(const f32x4*)(gl + c0), g1 = *(const f32x4*)(gl + c0 + 4);
            *(GAS v4u*)(Y + row * DM + DATT + c0) = pack8(y[k][0] * rn * g0, y[k][1] * rn * g1);
        }
    }
    if (ATT_HALF) {
        f32x4 y[8][2]; float s = 0.f;
#pragma unroll
        for (int k = 0; k < 8; ++k) { const int c0 = (l8 + 8 * k) * 8; const v4u v = *(const GAS v4u*)(Y + row * DM + c0); y[k][0] = lo4(v); y[k][1] = hi4(v); s += sum8sq(y[k][0], y[k][1]); }
        s += __shfl_xor(s, 1); s += __shfl_xor(s, 2); s += __shfl_xor(s, 4);
        const float rn = rsqrtf(s * (1.0f / DATT) + EPS);
#pragma unroll
        for (int k = 0; k < 8; ++k) {
            const int c0 = (l8 + 8 * k) * 8; const f32x4 g0 = *(const f32x4*)(gat + c0), g1 = *(const f32x4*)(gat + c0 + 4);
            *(GAS v4u*)(Y + row * DM + c0) = pack8(y[k][0] * rn * g0, y[k][1] * rn * g1);
        }
    }
    __syncthreads();
}
}

__device__ __forceinline__ int win_rowmap(int L) {
    const int tile = L >> 8, l = L & 255; int p;
    if (tile < 3) p = (((l >> 5) & 1) << 7) | ((l >> 6) << 5) | (l & 31);
    else { const int lo = l & 31; p = (l & ~31) | (((lo >> 2) & 1) << 4) | ((lo >> 3) << 2) | (lo & 3); }
    return tile * 256 + p;
}
template <bool MAP>
__device__ __forceinline__ void p0_transpose_item(const float* W, int K, int N, bf16* WT, const float* g, LAS float* scr, int item, int lane) {
    const int nblk = N / 32, kb = item / nblk, nb = item % nblk, k0 = 64 * kb, n0 = 32 * nb;
    float wv[32];
#pragma unroll
    for (int i = 0; i < 32; ++i) wv[i] = W[(size_t)(k0 + 2 * i + (lane >> 5)) * N + n0 + (lane & 31)];
#pragma unroll
    for (int i = 0; i < 32; ++i) { const int kk = 2 * i + (lane >> 5); float v = wv[i]; if (g) v *= g[k0 + kk]; scr[kk * 33 + (lane & 31)] = v; }
    LDS_WAIT(); asm volatile("" ::: "memory");
    const int c = lane & 7;
#pragma unroll
    for (int j = 0; j < 4; ++j) { const int n = (lane >> 3) + 8 * j; const LAS float* s = scr + (8 * c) * 33 + n;
        v4u o; o.x = pk2(s[0 * 33], s[1 * 33]); o.y = pk2(s[2 * 33], s[3 * 33]); o.z = pk2(s[4 * 33], s[5 * 33]); o.w = pk2(s[6 * 33], s[7 * 33]);
        const int row = MAP ? win_rowmap(n0 + n) : (n0 + n);
        *(GAS v4u*)(WT + (size_t)row * K + k0 + 8 * c) = o; }
    LDS_WAIT(); asm volatile("" ::: "memory");
}
__device__ __forceinline__ void p0_prologue(Frame& F) {
    LAS float* scr = (LAS float*)(F.lds + RING_OFF + F.wave * 16384);
    const int gw = F.vcu * NWAVES + F.wave, NGW = F.G * NWAVES;
    constexpr int I_IN = (DM / 64) * (DIN / 32), I_OUT = (DM / 64) * (DM / 32), I_UP = (DM / 64) * (DFF / 32), I_DN = (DFF / 64) * (DM / 32), I_G = I_OUT, I_P = (DPLE / 64) * (DM / 32);
    constexpr int NITEMS = I_IN + I_OUT + I_UP + I_DN + I_G + I_P;
    unsigned char* ws = F.ws;
    for (int it = gw; it < NITEMS; it += NGW) {
        int r = it;
        if (r < I_IN) { p0_transpose_item<true>(F.in[3], DM, DIN, (bf16*)(ws + WS_WIN), F.in[2], scr, r, F.lane); continue; } r -= I_IN;
        if (r < I_OUT) { p0_transpose_item<false>(F.in[15], DM, DM, (bf16*)(ws + WS_WOUT), nullptr, scr, r, F.lane); continue; } r -= I_OUT;
        if (r < I_UP) { p0_transpose_item<false>(F.in[17], DM, DFF, (bf16*)(ws + WS_WUP), F.in[16], scr, r, F.lane); continue; } r -= I_UP;
        if (r < I_DN) { p0_transpose_item<false>(F.in[18], DFF, DM, (bf16*)(ws + WS_WDOWN), nullptr, scr, r, F.lane); continue; } r -= I_DN;
        if (r < I_G) { p0_transpose_item<false>(F.in[20], DM, DM, (bf16*)(ws + WS_WG), F.in[19], scr, r, F.lane); continue; } r -= I_G;
        p0_transpose_item<false>(F.in[21], DPLE, DM, (bf16*)(ws + WS_WP), nullptr, scr, r, F.lane);
    }
    const float* x = F.in[0]; const float* p = F.in[1]; float* RSX = (float*)(ws + WS_RSX); bf16* XB = (bf16*)(ws + WS_HB); bf16* PB = (bf16*)(ws + WS_PB);
    for (int m0 = gw; m0 < T; m0 += 2 * NGW) {
        f32x4 v[2][4]; f32x4 pv[2]; float s[2];
#pragma unroll
        for (int q = 0; q < 2; ++q) { const int m = m0 + q * NGW; const GAS f32x4* xr = (const GAS f32x4*)(x + (size_t)m * DM) + F.lane;
#pragma unroll
            for (int j = 0; j < 4; ++j) v[q][j] = xr[64 * j];
            pv[q] = *((const GAS f32x4*)(p + (size_t)m * DPLE) + F.lane); }
#pragma unroll
        for (int q = 0; q < 2; ++q) { s[q] = 0.f;
#pragma unroll
            for (int j = 0; j < 4; ++j) s[q] += (v[q][j].x * v[q][j].x + v[q][j].y * v[q][j].y) + (v[q][j].z * v[q][j].z + v[q][j].w * v[q][j].w);
            s[q] = wave_sum(s[q]); }
#pragma unroll
        for (int q = 0; q < 2; ++q) { const int m = m0 + q * NGW;
            if (F.lane == 0) RSX[m] = rsqrtf(s[q] * (1.0f / DM) + EPS);
            GAS unsigned long long* o8 = (GAS unsigned long long*)(XB + (size_t)m * DM) + F.lane;
#pragma unroll
            for (int j = 0; j < 4; ++j) o8[64 * j] = (unsigned long long)pk2(v[q][j].x, v[q][j].y) | ((unsigned long long)pk2(v[q][j].z, v[q][j].w) << 32);
            *((GAS unsigned long long*)(PB + (size_t)m * DPLE) + F.lane) = (unsigned long long)pk2(pv[q].x, pv[q].y) | ((unsigned long long)pk2(pv[q].z, pv[q].w) << 32); }
    }
    { bf16* LW = (bf16*)(ws + WS_LW);
      for (int idx = (F.vcu * NWAVES + F.wave) * 64 + F.lane; idx < NBLK * 256 * 64; idx += F.G * NWAVES * 64) {
          const int n = idx >> 14, col = (idx >> 6) & 255, k = idx & 63, e = col >> 7, gsel = (col >> 6) & 1, j = col & 63;
          const float* src = gsel ? F.in[10] : F.in[8]; LW[idx] = (bf16)f2bf(src[(((size_t)e * NBLK + n) * 64 + k) * 64 + j]); } }
    float* rope = (float*)(ws + WS_ROPE);
    for (int idx = (F.vcu * NWAVES + F.wave) * 64 + F.lane; idx < 1024; idx += F.G * NWAVES * 64) {
        const int pos = idx >> 4, i = idx & 15; const float fr = powf(10000.f, -(float)i / 16.f); const float ang = (float)pos * fr;
        rope[idx] = cosf(ang); rope[1024 + idx] = sinf(ang);
    }
}

#ifndef REP
#define REP 0
#endif
#ifndef PHC
#define PHC 0x1ff
#endif
struct Args { const float* in[23]; float* out; unsigned char* ws; int ph_lo, ph_hi, li, flags; };
constexpr int NPHASE = 9;
__global__ void __launch_bounds__(NWAVES * 64, 2) mega(Args args) {
    extern __shared__ __attribute__((aligned(16))) unsigned char lds[];
    Frame F;
    F.lds = (LAS unsigned char*)lds;
    F.MISC = (volatile LAS unsigned*)(F.lds + MISC_OFF);
    F.tid = threadIdx.x; F.lane = F.tid & 63; F.wave = __builtin_amdgcn_readfirstlane(F.tid >> 6);
    F.G = gridDim.x; { const int bx = blockIdx.x; F.vcu = (F.G % 8 == 0) ? (bx % 8) * (F.G / 8) + bx / 8 : bx; }
    unsigned char* ws = args.ws; F.ws = ws; F.out = args.out;
#pragma unroll
    for (int i = 0; i < 23; ++i) F.in[i] = args.in[i];
    F.ctl = (gu32*)(ws + WS_CTL);
    for (int u = F.tid; u < (LDS_BYTES - LDSCTL_OFF) / 4; u += NWAVES * 64) ((LAS unsigned*)(F.lds + LDSCTL_OFF))[u] = 0u;
    __syncthreads();
    const int lo = args.ph_lo, hi = args.ph_hi;
    XcdBarrier bar; bar.bar = (unsigned*)(F.ctl + CW_BAR) + args.li * XCD_BAR_WORDS; bar.x = 0; bar.st = nullptr;
    if (hi - lo > 1) bar = xcd_barrier_post((unsigned*)(F.ctl + CW_BAR) + args.li * XCD_BAR_WORDS, F.MISC + 8);
#define GRID_BAR() xcd_barrier(bar)
#define IN(k) (lo <= (k) && (k) < hi)
#define BOTH(k) (IN(k) && IN((k) + 1))
    bf16* const XB = (bf16*)(ws + WS_HB); bf16* const HB = (bf16*)(ws + WS_HB); bf16* const PB = (bf16*)(ws + WS_PB); bf16* const PP = (bf16*)(ws + WS_PP);
    bf16* const Qb = (bf16*)(ws + WS_Q); bf16* const Kb = (bf16*)(ws + WS_K); bf16* const Vb = (bf16*)(ws + WS_V); bf16* const XR = (bf16*)(ws + WS_XR); bf16* const XG = (bf16*)(ws + WS_XG);
    bf16* const Y = (bf16*)(ws + WS_Y); bf16* const Mb = (bf16*)(ws + WS_M); bf16* const H3B = (bf16*)(ws + WS_H3B);
    float* const RSX = (float*)(ws + WS_RSX); float* const ROPE = (float*)(ws + WS_ROPE);
    float* const SS1 = (float*)(ws + WS_SS1); float* const SS2 = (float*)(ws + WS_SS2); float* const SS3 = (float*)(ws + WS_SS3);

    if ((PHC >> 0 & 1) && IN(0)) { p0_prologue(F);
#if REP & 1
        __syncthreads(); p0_prologue(F);
#endif
        if (BOTH(0)) GRID_BAR(); }

    if ((PHC >> 1 & 1) && IN(1)) {
        { pg8::Gemm g{XB, (const bf16*)(ws + WS_WIN), T, DIN, DM}; pg8::StaticOrder S; S.init(T, DIN, F.G, (int)blockIdx.x);
          pg8::EpiIn E{RSX, F.in[4], F.in[5], ROPE, Qb, Kb, Vb, XR, XG};
          pg8::gemm_phase<pg8::EpiIn, pg8::StaticOrder, PG8_ALIGN, PG8_SP2>(F.lds + RING_OFF, g, S, E);
#if REP & 2
          pg8::gemm_phase<pg8::EpiIn, pg8::StaticOrder, PG8_ALIGN, PG8_SP2>(F.lds + RING_OFF, g, S, E);
#endif
        }
        if (BOTH(1)) GRID_BAR();
    }

    if ((PHC >> 2 & 1) && IN(2)) {
        if (args.flags & 1) {
            const attn_body::AttnTensors AT{(const attn_body::bf16*)Qb, (const attn_body::bf16*)Kb, (const attn_body::bf16*)Vb, (attn_body::bf16*)Y};
            const attn_body::StaticOrder S(F.vcu);
            attn_body::attn_phase<8>((char*)lds + RING_OFF, AT, S);
#if REP & 4
            attn_body::attn_phase<8>((char*)lds + RING_OFF, AT, S);
#endif
        }
        if (args.flags & 2) lru::pass1(F);
#if REP & 8
        if (args.flags & 2) lru::pass1(F);
#endif
#if REP & 512
        for (int rb = 0; rb < 8; ++rb) GRID_BAR();
#endif
        if (BOTH(2)) GRID_BAR();
    }
    if ((PHC >> 3 & 1) && IN(3)) {
        if (args.flags & 4) lru::pass2<true>(F);
#if REP & 16
        if (args.flags & 4) lru::pass2<false>(F);
#endif
        { pg8::Gemm g{PB, (const bf16*)(ws + WS_WP), T, DM, DPLE}; pg8::StaticOrder S; S.init(T, DM, F.G, (int)blockIdx.x);
          pg8::EpiBf16<0> E{PP, DM, nullptr, 0, 0, 1.f};
          pg8::gemm_phase<pg8::EpiBf16<0>, pg8::StaticOrder, PG8_ALIGN, PG8_SP2>(F.lds + RING_OFF, g, S, E);
#if REP & 1024
          pg8::gemm_phase<pg8::EpiBf16<0>, pg8::StaticOrder, PG8_ALIGN, PG8_SP2>(F.lds + RING_OFF, g, S, E);
#endif
        }
        if (BOTH(3)) GRID_BAR();
    }
    if ((PHC >> 4 & 1) && IN(4)) {
        pg8::Gemm g{Y, (const bf16*)(ws + WS_WOUT), T, DM, DM}; pg8::StaticOrder S; S.init(T, DM, F.G, (int)blockIdx.x);
        pg8::EpiRes<true> E{HB, SS1};
        pg8::gemm_phase<pg8::EpiRes<true>, pg8::StaticOrder, PG8_ALIGN, PG8_SP2>(F.lds + RING_OFF, g, S, E);
#if REP & 32
        pg8::gemm_phase<pg8::EpiRes<true>, pg8::StaticOrder, PG8_ALIGN, PG8_SP2>(F.lds + RING_OFF, g, S, E);
#endif
        if (BOTH(4)) GRID_BAR();
    }
    if ((PHC >> 5 & 1) && IN(5)) {
        pg8::Gemm g{HB, (const bf16*)(ws + WS_WUP), T, DFF, DM}; pg8::StaticOrder S; S.init(T, DFF, F.G, (int)blockIdx.x);
        pg8::EpiUp E{SS1, Mb};
        pg8::gemm_phase<pg8::EpiUp, pg8::StaticOrder, PG8_ALIGN, PG8_SP2>(F.lds + RING_OFF, g, S, E);
#if REP & 64
        pg8::gemm_phase<pg8::EpiUp, pg8::StaticOrder, PG8_ALIGN, PG8_SP2>(F.lds + RING_OFF, g, S, E);
#endif
        if (BOTH(5)) GRID_BAR();
    }
    if ((PHC >> 6 & 1) && IN(6)) {
        pg8::Gemm g{Mb, (const bf16*)(ws + WS_WDOWN), T, DM, DFF}; pg8::StaticOrder S; S.init(T, DM, F.G, (int)blockIdx.x);
#if REP & 128
        { pg8::EpiRes<false> E0{HB, SS2}; pg8::gemm_phase<pg8::EpiRes<false>, pg8::StaticOrder, PG8_ALIGN, PG8_SP2>(F.lds + RING_OFF, g, S, E0); }
#endif
        pg8::EpiRes<true> E{HB, SS2};
        pg8::gemm_phase<pg8::EpiRes<true>, pg8::StaticOrder, PG8_ALIGN, PG8_SP2>(F.lds + RING_OFF, g, S, E);
        if (BOTH(6)) GRID_BAR();
    }
    if ((PHC >> 7 & 1) && IN(7)) {
        pg8::Gemm g{HB, (const bf16*)(ws + WS_WG), T, DM, DM}; pg8::StaticOrder S; S.init(T, DM, F.G, (int)blockIdx.x);
#if REP & 256
        { pg8::EpiGate<false> E0{SS2, PP, HB, H3B, SS3}; pg8::gemm_phase<pg8::EpiGate<false>, pg8::StaticOrder, PG8_ALIGN, PG8_SP2>(F.lds + RING_OFF, g, S, E0); }
#endif
        pg8::EpiGate<true> E{SS2, PP, HB, H3B, SS3};
        pg8::gemm_phase<pg8::EpiGate<true>, pg8::StaticOrder, PG8_ALIGN, PG8_SP2>(F.lds + RING_OFF, g, S, E);
        if (BOTH(7)) GRID_BAR();
    }
    if ((PHC >> 8 & 1) && IN(8)) {
        const int gw = F.vcu * NWAVES + F.wave, NGW = F.G * NWAVES; const float* gf = F.in[22];
        for (int m = gw; m < T; m += NGW) {
            const float rs = pg8::rstd16(SS3 + (size_t)m * 16);
            GAS f32x4* o = (GAS f32x4*)(F.out + (size_t)m * DM) + F.lane; const GAS unsigned long long* hsrc = (const GAS unsigned long long*)(H3B + (size_t)m * DM) + F.lane;
#pragma unroll
            for (int j = 0; j < 4; ++j) { const f32x4 gv = *((const GAS f32x4*)gf + F.lane + 64 * j); const unsigned long long hw = hsrc[64 * j];
                f32x4 v; v[0] = __uint_as_float((unsigned)hw << 16); v[1] = __uint_as_float((unsigned)hw & 0xffff0000u); v[2] = __uint_as_float((unsigned)(hw >> 32) << 16); v[3] = __uint_as_float((unsigned)(hw >> 32) & 0xffff0000u);
                o[64 * j] = v * rs * gv; }
        }
    }
#undef IN
#undef BOTH
#undef GRID_BAR
}

#ifndef MEGA_MASK
#define MEGA_MASK 0x01
#endif
extern "C" void kernel_launch(void* const* d_in, const int* in_sizes, int n_in, void* d_out, int out_size, void* d_ws, size_t ws_size, hipStream_t stream) {
    static int grid = 0;
    if (grid == 0) {
        if (n_in != 23 || in_sizes[0] != T * DM || out_size != T * DM || ws_size < WS_END) { fprintf(stderr, "kernel_launch: unexpected shapes (n_in %d, in0 %d, out %d, ws %zu)\n", n_in, n_in > 0 ? in_sizes[0] : -1, out_size, ws_size); grid = -1; return; }
        int dev = 0, cus = 0, per_cu = 0;
        if (hipGetDevice(&dev) != hipSuccess || hipDeviceGetAttribute(&cus, hipDeviceAttributeMultiprocessorCount, dev) != hipSuccess) { grid = -1; return; }
        if (hipFuncSetAttribute((const void*)mega, hipFuncAttributeMaxDynamicSharedMemorySize, LDS_BYTES) != hipSuccess) { fprintf(stderr, "kernel_launch: hipFuncSetAttribute failed\n"); grid = -1; return; }
        if (hipOccupancyMaxActiveBlocksPerMultiprocessor(&per_cu, (const void*)mega, NWAVES * 64, LDS_BYTES) != hipSuccess || per_cu < 1) { fprintf(stderr, "kernel_launch: occupancy query says %d blocks per CU\n", per_cu); (void)hipGetLastError(); grid = -1; return; }
        grid = cus;
        if (grid != 256) fprintf(stderr, "kernel_launch: %d CUs; this kernel's unit maps assume 256\n", grid);
    }
    if (grid < 0) return;
    const float* in[23]; for (int i = 0; i < 23; ++i) in[i] = (const float*)d_in[i];
    unsigned char* ws = (unsigned char*)d_ws; float* out = (float*)d_out;
    (void)hipMemsetAsync(ws + WS_CTL, 0, CTL_ZERO_BYTES, stream);
    Args a{}; for (int i = 0; i < 23; ++i) a.in[i] = in[i]; a.out = out; a.ws = ws;
    int li = 0;
    auto launch = [&](int lo, int hi, int flags) {
        a.ph_lo = lo; a.ph_hi = hi; a.li = li++; a.flags = flags;
        if (hi - lo > 1) { void* kargs[] = {(void*)&a}; hipError_t e = hipLaunchCooperativeKernel((const void*)mega, dim3(grid), dim3(NWAVES * 64), kargs, LDS_BYTES, stream);
            if (e != hipSuccess) fprintf(stderr, "kernel_launch: cooperative launch failed: %s\n", hipGetErrorString(e)); }
        else hipLaunchKernelGGL(mega, dim3(grid), dim3(NWAVES * 64), LDS_BYTES, stream, a);
    };
    constexpr int MM = MEGA_MASK;
    if (MM == 0x7f) { launch(0, NPHASE, 7); return; }
    bf16_t* Q = (bf16_t*)(ws + WS_Q); bf16_t* K = (bf16_t*)(ws + WS_K); bf16_t* V = (bf16_t*)(ws + WS_V); bf16_t* XR = (bf16_t*)(ws + WS_XR); bf16_t* XG = (bf16_t*)(ws + WS_XG);
    bf16_t* Y = (bf16_t*)(ws + WS_Y); bf16_t* M = (bf16_t*)(ws + WS_M);
    float* HF = out; float* HBs = out + (size_t)T * DLRU;
    if (MM & 0x01) launch(0, 2, 0); else nv::s1<<<T / 4, 256, 0, stream>>>(in[0], in[2], in[3], in[4], in[5], Q, K, V, XR, XG);
    if (MM & 0x02) launch(2, 3, 1); else nv::attn<<<dim3(SEQ / 128, NQH, BATCH), 128, 0, stream>>>(Q, K, V, Y);
    if (MM & 0x04) { launch(2, 3, 2); launch(3, 4, 4); }
    else { nv::lru<<<BATCH * NBLK, 128, 0, stream>>>(XR, in[6], in[7], in[8], in[9], in[10], in[11], in[12], HF, HBs); nv::merge<<<T, 256, 0, stream>>>(Y, HF, HBs, XG, in[13], in[14]);
           if (MM & 0x40) launch(3, 4, 0); }
    if (MM & 0x08) launch(4, 5, 0); else nv::s4<<<T / 4, 256, 0, stream>>>(in[0], Y, in[15], out);
    if (MM & 0x10) launch(5, 6, 0); else nv::s5<<<T / 4, 256, 0, stream>>>(out, in[16], in[17], M);
    if (MM & 0x20) launch(6, 7, 0); else nv::s6<<<T / 4, 256, 0, stream>>>(out, M, in[18]);
    if (MM & 0x40) launch(7, 9, 0); else nv::s7<<<T / 4, 256, 0, stream>>>(out, in[1], in[19], in[20], in[21], in[22]);
}
```
